# Optimizing an MI355X kernel written in HIP

```python
import jax, jax.numpy as jnp
from jax import lax
import numpy as np

D_MODEL = 1024
BATCH = 4
SEQ = 4096
DEPTH = 1

HEAD_DIM = 64
N_MIX_HEADS = D_MODEL // HEAD_DIM
A_Q_HEADS = N_MIX_HEADS // 2
A_KV_HEADS = max(1, A_Q_HEADS // 4)
A_HALF_WINDOW = 128
B_HEADS = N_MIX_HEADS - A_Q_HEADS
B_BRANCHES = ((128, 1), (512, 4), (2048, 16))
ATTN_BLOCK = 128
N_ALIBI_HEADS = A_Q_HEADS + B_HEADS
A_Q_W = A_Q_HEADS * HEAD_DIM
A_KV_W = A_KV_HEADS * HEAD_DIM
B_W = B_HEADS * HEAD_DIM
IN_PROJ_W = A_Q_W + 2 * A_KV_W + 3 * B_W
MIX_W = A_Q_W + B_W
N_EXPERTS = 32
TOP_K = 4
D_FF = D_MODEL
SWIGLU_ALPHA = 1.702
SWIGLU_LIMIT = 7.0
MOE_ROW_BLOCK = 128
NORM_EPS = 1e-5
MASK_VALUE = -1e30

kernel_name = "hymba_style_sink_gqa_dilated_moe_encoder"


def rms_norm(x, g):
    xf = x.astype(jnp.float32)
    y = xf * lax.rsqrt(jnp.mean(xf * xf, axis=-1, keepdims=True) + NORM_EPS)
    return (y * g.astype(jnp.float32)).astype(x.dtype)


def alibi_slopes(n):
    return jnp.exp2(-8.0 * jnp.arange(1, n + 1, dtype=jnp.float32) / n)


def banded_attention(q, k, v, half_w, dist_scale, slopes, sink=None):
    n, h, r, L, hd = q.shape
    blk = min(ATTN_BLOCK, L)
    nb = -(-L // blk)
    lp = nb * blk
    kw = blk + 2 * half_w
    qb = jnp.pad(q, ((0, 0), (0, 0), (0, 0), (0, lp - L), (0, 0))).reshape(n, h, r, nb, blk, hd)
    pad_k = ((0, 0), (0, 0), (half_w, lp - L + half_w), (0, 0))
    kidx = jnp.arange(nb)[:, None] * blk + jnp.arange(kw)[None, :]
    kb = jnp.pad(k, pad_k)[:, :, kidx]
    vb = jnp.pad(v, pad_k)[:, :, kidx]
    s = jnp.einsum('nhrbqd,nhbkd->nhrbqk', qb, kb).astype(jnp.float32) * (hd ** -0.5)
    qpos = jnp.arange(nb)[:, None] * blk + jnp.arange(blk)[None, :]
    kpos = kidx - half_w
    dist = jnp.abs(qpos[:, :, None] - kpos[:, None, :])
    valid = (dist <= half_w) & (kpos >= 0)[:, None, :] & (kpos < L)[:, None, :]
    bias = -slopes.astype(jnp.float32)[:, :, None, None, None] * (dist * dist_scale).astype(jnp.float32)
    s = jnp.where(valid, s + bias, MASK_VALUE)
    m = jnp.max(s, axis=-1)
    if sink is not None:
        sink_f = sink.astype(jnp.float32)[:, :, None, None]
        m = jnp.maximum(m, sink_f)
    p = jnp.exp(s - m[..., None])
    denom = jnp.sum(p, axis=-1)
    if sink is not None:
        denom = denom + jnp.exp(sink_f - m)
    o = jnp.einsum('nhrbqk,nhbkd->nhrbqd', p, vb.astype(jnp.float32)) / denom[..., None]
    o = o.reshape(n, h, r, lp, hd)[:, :, :, :L].astype(q.dtype)
    lse = (m + jnp.log(denom)).reshape(n, h, r, lp)[..., :L]
    return o, lse


def windowed_sink_gqa(q, k, v, q_gain, k_gain, sinks, slopes):
    b, s, hq, hd = q.shape
    hkv = k.shape[2]
    r = hq // hkv
    q = rms_norm(q, q_gain)
    k = rms_norm(k, k_gain)
    qh = q.reshape(b, s, hkv, r, hd).transpose(0, 2, 3, 1, 4)
    kh = k.transpose(0, 2, 1, 3)
    vh = v.transpose(0, 2, 1, 3)
    o, _ = banded_attention(qh, kh, vh, A_HALF_WINDOW, 1,
                            slopes.reshape(hkv, r), sinks.reshape(hkv, r))
    return o.transpose(0, 3, 1, 2, 4).reshape(b, s, hq * hd)


def to_strided(t, dil):
    b, s, h, hd = t.shape
    return t.reshape(b, s // dil, dil, h, hd).transpose(0, 2, 3, 1, 4).reshape(b * dil, h, s // dil, hd)


def dilated_attention(q, k, v, q_gain, k_gain, slopes):
    b, s, h, hd = q.shape
    q = rms_norm(q, q_gain)
    k = rms_norm(k, k_gain)
    outs, lses = [], []
    for window, dil in B_BRANCHES:
        L = s // dil
        o, lse = banded_attention(to_strided(q, dil)[:, :, None], to_strided(k, dil),
                                  to_strided(v, dil), window // (2 * dil), dil, slopes[:, None])
        o = o[:, :, 0].reshape(b, dil, h, L, hd).transpose(0, 3, 1, 2, 4).reshape(b, s, h, hd)
        lse = lse[:, :, 0].reshape(b, dil, h, L).transpose(0, 3, 1, 2).reshape(b, s, h)
        outs.append(o.astype(jnp.float32))
        lses.append(lse)
    w = jax.nn.softmax(jnp.stack(lses), axis=0)
    o = jnp.sum(w[..., None] * jnp.stack(outs), axis=0)
    return o.reshape(b, s, h * hd).astype(q.dtype)


def moe_ffn(h, w_router, b_router, w1, b1, w2, b2):
    bsz, s, d = h.shape
    n = bsz * s
    g = MOE_ROW_BLOCK
    hf = h.reshape(n, d)
    logits = (hf @ w_router).astype(jnp.float32) + b_router.astype(jnp.float32)
    top_v, top_i = lax.top_k(logits, TOP_K)
    gates = jax.nn.softmax(top_v, axis=-1)
    nk = n * TOP_K
    flat_e = top_i.reshape(nk)
    flat_tok = jnp.repeat(jnp.arange(n, dtype=jnp.int32), TOP_K)
    order = jnp.argsort(flat_e)
    se = flat_e[order]
    stok = flat_tok[order]
    sgate = gates.reshape(nk)[order]
    counts = jnp.bincount(flat_e, length=N_EXPERTS)
    starts = jnp.cumsum(counts) - counts
    pcounts = (counts + g - 1) // g * g
    pends = jnp.cumsum(pcounts)
    pstarts = pends - pcounts
    dest = pstarts[se] + jnp.arange(nk, dtype=jnp.int32) - starts[se]
    n_rows = nk + N_EXPERTS * g
    n_blk = n_rows // g
    row_tok = jnp.zeros((n_rows,), jnp.int32).at[dest].set(stok)
    blk_exp = jnp.minimum(jnp.searchsorted(pends, jnp.arange(n_blk, dtype=jnp.int32) * g, side='right'),
                          N_EXPERTS - 1)
    xb = hf[row_tok].reshape(n_blk, g, d)

    def expert_block(args):
        xg, e = args
        a = xg @ w1[e] + b1[e]
        glu, lin = a[:, :D_FF], a[:, D_FF:]
        glu = jnp.minimum(glu, SWIGLU_LIMIT)
        lin = jnp.clip(lin, -SWIGLU_LIMIT, SWIGLU_LIMIT)
        act = glu * jax.nn.sigmoid(SWIGLU_ALPHA * glu) * (lin + 1)
        return act @ w2[e] + b2[e]

    y = lax.map(expert_block, (xb, blk_exp)).reshape(n_rows, d)
    contrib = y[dest] * sgate[:, None].astype(y.dtype)
    return jax.ops.segment_sum(contrib, stok, num_segments=n).reshape(bsz, s, d)


def setup_inputs(seed: int = 0) -> dict:
    key = jax.random.key(seed)
    ks = jax.random.split(key, 16)
    f32 = jnp.float32
    nrm = lambda k, shape, sc: jax.random.normal(k, shape, f32) * sc
    return {
        "x": jax.random.normal(ks[0], (BATCH, SEQ, D_MODEL), f32),
        "attn_norm_g": 1.0 + nrm(ks[1], (DEPTH, D_MODEL), 0.02),
        "w_in": nrm(ks[2], (DEPTH, D_MODEL, IN_PROJ_W), D_MODEL ** -0.5),
        "a_q_norm_g": 1.0 + nrm(ks[3], (DEPTH, HEAD_DIM), 0.02),
        "a_k_norm_g": 1.0 + nrm(ks[4], (DEPTH, HEAD_DIM), 0.02),
        "a_sinks": nrm(ks[5], (DEPTH, A_Q_HEADS), 0.5),
        "b_q_norm_g": 1.0 + nrm(ks[6], (DEPTH, HEAD_DIM), 0.02),
        "b_k_norm_g": 1.0 + nrm(ks[7], (DEPTH, HEAD_DIM), 0.02),
        "w_out": nrm(ks[8], (DEPTH, MIX_W, D_MODEL), MIX_W ** -0.5),
        "ffn_norm_g": 1.0 + nrm(ks[9], (DEPTH, D_MODEL), 0.02),
        "w_router": nrm(ks[10], (DEPTH, D_MODEL, N_EXPERTS), D_MODEL ** -0.5),
        "b_router": nrm(ks[11], (DEPTH, N_EXPERTS), 0.01),
        "w1": nrm(ks[12], (DEPTH, N_EXPERTS, D_MODEL, 2 * D_FF), D_MODEL ** -0.5),
        "b1": nrm(ks[13], (DEPTH, N_EXPERTS, 2 * D_FF), 0.02),
        "w2": nrm(ks[14], (DEPTH, N_EXPERTS, D_FF, D_MODEL), D_FF ** -0.5),
        "b2": nrm(ks[15], (DEPTH, N_EXPERTS, D_MODEL), 0.02),
    }


def reference(x, attn_norm_g, w_in, a_q_norm_g, a_k_norm_g, a_sinks, b_q_norm_g, b_k_norm_g,
              w_out, ffn_norm_g, w_router, b_router, w1, b1, w2, b2):
    bsz, s, _ = x.shape
    slopes = alibi_slopes(N_ALIBI_HEADS)
    slopes_a = slopes[:A_Q_HEADS]
    slopes_b = slopes[A_Q_HEADS:]
    splits = np.cumsum([A_Q_W, A_KV_W, A_KV_W, B_W, B_W]).tolist()
    for i in range(DEPTH):
        hn = rms_norm(x, attn_norm_g[i])
        proj = hn @ w_in[i]
        qa, ka, va, qb, kb, vb = jnp.split(proj, splits, axis=-1)
        out_a = windowed_sink_gqa(qa.reshape(bsz, s, A_Q_HEADS, HEAD_DIM),
                                  ka.reshape(bsz, s, A_KV_HEADS, HEAD_DIM),
                                  va.reshape(bsz, s, A_KV_HEADS, HEAD_DIM),
                                  a_q_norm_g[i], a_k_norm_g[i], a_sinks[i], slopes_a)
        out_b = dilated_attention(qb.reshape(bsz, s, B_HEADS, HEAD_DIM),
                                  kb.reshape(bsz, s, B_HEADS, HEAD_DIM),
                                  vb.reshape(bsz, s, B_HEADS, HEAD_DIM),
                                  b_q_norm_g[i], b_k_norm_g[i], slopes_b)
        x = x + jnp.concatenate([out_a, out_b], axis=-1) @ w_out[i]
        hf = rms_norm(x, ffn_norm_g[i])
        x = x + moe_ffn(hf, w_router[i], b_router[i], w1[i], b1[i], w2[i], b2[i])
    return x
```

```cpp
#include <hip/hip_runtime.h>
#include <hip/hip_bf16.h>
#include <cstdio>
#include <cstdint>

#define LAS __attribute__((address_space(3)))
#define GAS __attribute__((address_space(1)))
typedef unsigned short bf16_t;
typedef short bf16x8 __attribute__((ext_vector_type(8)));
typedef short s16x4 __attribute__((ext_vector_type(4)));
typedef float f32x4 __attribute__((ext_vector_type(4)));
typedef float f32x2 __attribute__((ext_vector_type(2)));
typedef float f32x16 __attribute__((ext_vector_type(16)));
typedef unsigned u32x4 __attribute__((ext_vector_type(4)));
typedef unsigned u32x2 __attribute__((ext_vector_type(2)));

constexpr int BATCH = 4, SEQ = 4096, DM = 1024, MTOK = BATCH * SEQ;
constexpr int HD = 64, NPROJ = 2304;
constexpr int COL_QA = 0, COL_KA = 512, COL_VA = 640, COL_QB = 768, COL_KB = 1280, COL_VB = 1792;
constexpr int NE = 32, TOPK = 4, DFF = 1024;
constexpr float NORM_EPS = 1e-5f;
constexpr float LOG2E = 1.4426950408889634f;
constexpr float C2 = 0.125f * LOG2E;
constexpr int LISTCAP = MTOK;

constexpr size_t MiB = 1u << 20;
constexpr size_t WS_CTL = 0, CTL_ZERO_BYTES = 1 * MiB;
constexpr size_t WS_WIN = 2 * MiB;
constexpr size_t WS_WOUT = 8 * MiB;
constexpr size_t WS_WRH = 10 * MiB;
constexpr size_t WS_WRL = 10 * MiB + 65536;
constexpr size_t WS_RT = 11 * MiB;
constexpr size_t WS_TOPE = 11 * MiB + 65536;
constexpr size_t WS_TOPS = WS_TOPE + 262144;
constexpr size_t WS_GATE = WS_TOPS + 262144;
constexpr size_t WS_LIST = 12 * MiB;
constexpr size_t WS_LB = 14 * MiB;
constexpr size_t WS_W1 = 16 * MiB;
constexpr size_t WS_W2 = 144 * MiB;
constexpr size_t WS_XN = 208 * MiB;
constexpr size_t WS_QKV = 240 * MiB;
constexpr size_t WS_OB = 312 * MiB;
constexpr size_t WS_ATT = 360 * MiB;
constexpr size_t WS_HN = 392 * MiB;
constexpr size_t WS_ACT = 424 * MiB;
constexpr size_t WS_Y = 568 * MiB;
constexpr size_t WS_X1 = 712 * MiB;
constexpr size_t WS_END = 776 * MiB;
constexpr int CW_BAR = 4096;
constexpr int CW_CNT = 16384;
constexpr int CW_RTC = 32768;

constexpr int RING_BYTES = 131072;
constexpr int XT_IDX = RING_BYTES;
constexpr int XT_TP = XT_IDX + 24576;
constexpr int XT_CNT = XT_TP + 160;
constexpr int XT_HIST = XT_CNT + 128;
constexpr int XT_BASE = XT_HIST + 128;
constexpr int LDS_BYTES = 163840;
constexpr int XT_MISC = LDS_BYTES - 128;
static_assert(XT_MISC + 128 <= LDS_BYTES && XT_BASE + 128 <= XT_MISC, "LDS map");
constexpr int ATT_NS = 18, ATT_STG = ATT_NS * 8192, ATT_WSF = ATT_STG + 8192;
static_assert(ATT_WSF + 1024 <= XT_MISC, "attention LDS map");

#define RLX_AGENT __ATOMIC_RELAXED, __HIP_MEMORY_SCOPE_AGENT
#define LDS_WAIT() asm volatile("s_waitcnt lgkmcnt(0)" ::: "memory")
#define VM_WAIT() asm volatile("s_waitcnt vmcnt(0)" ::: "memory")

__device__ __forceinline__ unsigned f2bf(float f) { unsigned u = __builtin_bit_cast(unsigned, f); return (u + 0x7fffu + ((u >> 16) & 1u)) >> 16; }
__device__ __forceinline__ unsigned pk2(float lo, float hi) { unsigned r; asm volatile("v_cvt_pk_bf16_f32 %0, %1, %2" : "=v"(r) : "v"(lo), "v"(hi)); return r; }
__device__ __forceinline__ float bf2f(unsigned h) { return __builtin_bit_cast(float, h << 16); }
__device__ __forceinline__ unsigned cvt_pk_bf16(float lo, float hi) { unsigned r; asm volatile("v_cvt_pk_bf16_f32 %0, %1, %2" : "=v"(r) : "v"(lo), "v"(hi)); return r; }
__device__ __forceinline__ float wave_sum(float v) {
#pragma unroll
    for (int o = 1; o < 64; o <<= 1) v += __shfl_xor(v, o);
    return v;
}
__device__ __forceinline__ float wave_max(float v) {
#pragma unroll
    for (int o = 1; o < 64; o <<= 1) v = fmaxf(v, __shfl_xor(v, o));
    return v;
}

namespace pg8 {
constexpr int BM = 256, BK = 64, HALF = 128, HTB = HALF * BK * 2, KDIM = 1024;
__host__ __device__ __forceinline__ int lds_byte(int r, int c) { const int st = (r >> 4) * 2 + (c >> 5), rr = r & 15, cc = c & 31, ob = rr * 64 + cc * 2; return st * 1024 + (ob ^ (((ob >> 9) & 1) << 5)); }
__host__ __device__ __forceinline__ void stage_rc(int b, int& R, int& C) { const int st = b / 1024, sb = b % 1024, swz = sb ^ (((sb >> 9) & 1) << 5); R = (st >> 1) * 16 + swz / 64; C = (st & 1) * 32 + (swz % 64) / 2; }
__host__ __device__ __forceinline__ int perm32(int rho) { const int n = rho >> 4, i = rho & 15; return 8 * (i >> 2) + 4 * n + (i & 3); }

struct UnitD { const char* A; const char* B; int pm, pn, e, ui, kind; unsigned bh; };

typedef int v8i __attribute__((ext_vector_type(8)));
typedef int v4i __attribute__((ext_vector_type(4)));
__device__ __forceinline__ void glds4_sc1(const void* gsrc, unsigned lds_dst) { unsigned keep;
    asm volatile("s_mov_b32 %0, m0\n\ts_mov_b32 m0, %2\n\ts_nop 0\n\tglobal_load_lds_dword %1, off sc1\n\ts_mov_b32 m0, %0" : "=&s"(keep) : "v"(gsrc), "s"(lds_dst) : "memory"); }
template <class Epi, class Sched, int BMODE, bool GATHER, bool FP8, bool FLOW = false>
__device__ __forceinline__ void gemm_phase(LAS unsigned char* lds, const Sched& S, const Epi& E, const unsigned bhstep) {
    constexpr int ROWB = FP8 ? 1024 : 2048, nt = FP8 ? 8 : 16;
    const int tid = threadIdx.x, wid = __builtin_amdgcn_readfirstlane(tid >> 6), lane = tid & 63, wr = wid >> 2, wc = wid & 3, fr = lane & 15, fq = lane >> 4;
    unsigned voffA[GATHER ? 2 : 1][2], voffB[2];
#pragma unroll
    for (int i = 0; i < 2; ++i) { int R, C; stage_rc(tid * 16 + i * 8192, R, C);
        const int Rb = BMODE == 0 ? R : (BMODE == 1 ? ((R & ~31) + perm32(R & 31)) : (2 * (R & ~31) + perm32(R & 31)));
        voffB[i] = (unsigned)(Rb * ROWB + C * 2);
        voffA[0][i] = (unsigned)(R * ROWB + C * 2); if constexpr (GATHER) voffA[1][i] = 0u; }
    int sclX = 0x7F7F7F7F; asm volatile("" : "+v"(sclX));
    const size_t kstep = (size_t)(BK * 2);
    const unsigned ldsw = (unsigned)wid * 1024u;
    const int aoff = lds_byte(wr * 64 + fr, fq * 8), boff = lds_byte(wc * 32 + fr, fq * 8);
    LAS unsigned char* Ap = lds + aoff; LAS unsigned char* Bp = lds + boff + 4 * HTB;
    asm volatile("" : "+v"(Ap)); asm volatile("" : "+v"(Bp));
#define PG8_SA(b, h) (((b) * 2 + (h)) * HTB)
#define PG8_SB(b, h) ((4 + (b) * 2 + (h)) * HTB)
#define PG8_STAGE_X(bufoff, gbase, voff, AUX) do { _Pragma("unroll") for (int _i = 0; _i < 2; ++_i) \
        __builtin_amdgcn_global_load_lds((const unsigned*)((const char*)(gbase) + (voff)[_i]), (LAS unsigned*)(lds + (bufoff) + ldsw + _i * 8192), 16, 0, AUX); } while (0)
#define PG8_STAGE(bufoff, gbase, voff) PG8_STAGE_X(bufoff, gbase, voff, 0)
#define PG8_STAGE_A(b, h, gbase) do { if constexpr (GATHER) { PG8_STAGE(PG8_SA(b, h), gbase, voffA[h]); } else { PG8_STAGE(PG8_SA(b, h), (gbase) + (h) * (HALF * ROWB), voffA[0]); } } while (0)
#define PG8_RDA(off) (*(const LAS v4i*)(Ap + (off)))
#define PG8_RDB(off) (*(const LAS v4i*)(Bp + (off)))
#define PG8_LDA(dst, b, h) do { _Pragma("unroll") for (int m = 0; m < 4; ++m) { if constexpr (FP8) dst##8[m] = __builtin_shufflevector(PG8_RDA(PG8_SA(b, h) + m * 2048), PG8_RDA(PG8_SA(b, h) + m * 2048 + 1024), 0, 1, 2, 3, 4, 5, 6, 7); \
        else { _Pragma("unroll") for (int k = 0; k < 2; ++k) dst[m][k] = __builtin_bit_cast(bf16x8, PG8_RDA(PG8_SA(b, h) + m * 2048 + k * 1024)); } } } while (0)
#define PG8_LDB(dst, b, h) do { _Pragma("unroll") for (int n = 0; n < 2; ++n) { if constexpr (FP8) dst##8[n] = __builtin_shufflevector(PG8_RDB(PG8_SA(b, h) + n * 2048), PG8_RDB(PG8_SA(b, h) + n * 2048 + 1024), 0, 1, 2, 3, 4, 5, 6, 7); \
        else { _Pragma("unroll") for (int k = 0; k < 2; ++k) dst[n][k] = __builtin_bit_cast(bf16x8, PG8_RDB(PG8_SA(b, h) + n * 2048 + k * 1024)); } } } while (0)
#define PG8_MMA(ai, bj, At, Bt) do { __builtin_amdgcn_s_setprio(1); _Pragma("unroll") for (int m = 0; m < 4; ++m) _Pragma("unroll") for (int n = 0; n < 2; ++n) { \
        if constexpr (FP8) { acc[ai][bj][m][n] = __builtin_amdgcn_mfma_scale_f32_16x16x128_f8f6f4(Bt##8[n], At##8[m], acc[ai][bj][m][n], 0, 0, 0, sclX, 0, sclX); } \
        else { _Pragma("unroll") for (int k = 0; k < 2; ++k) acc[ai][bj][m][n] = __builtin_amdgcn_mfma_f32_16x16x32_bf16(Bt[n][k], At[m][k], acc[ai][bj][m][n], 0, 0, 0); } } \
        __builtin_amdgcn_s_setprio(0); } while (0)
#define PG8_WAIT_V(n) asm volatile("s_waitcnt vmcnt(" #n ")" ::: "memory")
#define PG8_WAIT_L(n) asm volatile("s_waitcnt lgkmcnt(" #n ")" ::: "memory")
#define PG8_BAR __builtin_amdgcn_s_barrier()
#define PG8_SCHED __builtin_amdgcn_sched_barrier(0)
#define PG8_GIDX(uord, U) do { if constexpr (GATHER) { const LAS int* _ix = S.idx(uord); _Pragma("unroll") for (int _i = 0; _i < 2; ++_i) { int R, C; stage_rc(tid * 16 + _i * 8192, R, C); \
        voffA[0][_i] = (unsigned)(_ix[R] * ROWB + C * 2); voffA[1][_i] = (unsigned)(_ix[R + HALF] * ROWB + C * 2); } } } while (0)
#define PG8_DEPSPIN(rt, c0) do { unsigned _c = (c0), _sp = 0; const unsigned* _p = S.cnt + (rt) * 16; \
        while (_c < 64u && ++_sp < (1u << 18)) { __builtin_amdgcn_s_sleep(2); unsigned _t; asm volatile("global_load_dword %0, %1, %2 sc1\n\ts_waitcnt vmcnt(0)" : "=v"(_t) : "v"(0), "s"(_p) : "memory"); _c = (unsigned)__builtin_amdgcn_readfirstlane(_t); } } while (0)
    UnitD cur, nxt; int ui = 0;
    if (!S.next(0, cur)) return;
    f32x4 acc[2][2][4][2];
#pragma unroll
    for (int a = 0; a < 2; ++a)
#pragma unroll
        for (int b = 0; b < 2; ++b)
#pragma unroll
            for (int m = 0; m < 4; ++m)
#pragma unroll
                for (int n = 0; n < 2; ++n) acc[a][b][m][n] = (f32x4){0.f, 0.f, 0.f, 0.f};
    bf16x8 At[FP8 ? 1 : 4][2], B0[2][2], B1[2][2]; v8i At8[4], B08[2], B18[2];
    const char* cA = cur.A; const char* cB = cur.B; unsigned cbh = bhstep; if constexpr (FLOW) cbh = cur.bh;
    const unsigned dslot = (unsigned)(size_t)(lds + XT_MISC + 96) + (unsigned)wid * 4u; int rtp = 0;
    if constexpr (FLOW) {
#pragma unroll
        for (int k = 0; k < 3; ++k) { int rt_; if (S.dep(k, rt_)) PG8_DEPSPIN(rt_, 0u); }
        if (lane == 0) asm volatile("ds_write_b32 %0, %1" :: "v"(dslot), "v"(64u) : "memory");
    }
    PG8_GIDX(0, cur);
    PG8_STAGE(PG8_SB(0, 0), cB, voffB); PG8_STAGE(PG8_SB(0, 1), cB + cbh, voffB); PG8_STAGE_A(0, 0, cA); PG8_STAGE_A(0, 1, cA);
    if (wr == 1) PG8_BAR;
    PG8_WAIT_V(2); PG8_BAR;
    PG8_STAGE(PG8_SB(1, 0), cB + kstep, voffB); PG8_STAGE_A(1, 0, cA + kstep); PG8_STAGE(PG8_SB(1, 1), cB + cbh + kstep, voffB);
    PG8_WAIT_V(6); PG8_BAR;
    for (;;) {
        const bool has_next = S.next(ui + 1, nxt);
        const char* nA = has_next ? nxt.A : cA; const char* nB = has_next ? nxt.B : cB; unsigned nbh = cbh; if constexpr (FLOW) nbh = has_next ? nxt.bh : cbh;
#pragma clang loop unroll(disable)
        for (int t = 0; t < nt; t += 2) {
            const bool last = (t == nt - 2);
            const char* a1 = cA + (size_t)(t + 1) * kstep;
            const char* a2 = last ? nA : cA + (size_t)(t + 2) * kstep; const char* b2 = last ? nB : cB + (size_t)(t + 2) * kstep;
            const char* a3 = a2 + kstep; const char* b3 = b2 + kstep; const unsigned bh2 = (FLOW && last) ? nbh : cbh;
            PG8_LDB(B0, 0, 0); PG8_LDB(B1, 0, 1); PG8_SCHED; PG8_LDA(At, 0, 0); PG8_STAGE_A(1, 1, a1);
            if (GATHER && last && has_next) { PG8_GIDX(ui + 1, nxt); }
            PG8_WAIT_V(8); PG8_WAIT_L(0); PG8_BAR; PG8_MMA(0, 0, At, B0); PG8_MMA(0, 1, At, B1); PG8_BAR; PG8_SCHED;
            PG8_LDA(At, 0, 1); PG8_STAGE(PG8_SB(0, 0), b2, voffB); PG8_STAGE(PG8_SB(0, 1), b2 + bh2, voffB); PG8_STAGE_A(0, 0, a2);
            PG8_WAIT_V(8); PG8_WAIT_L(0); PG8_BAR; PG8_MMA(1, 0, At, B0); PG8_MMA(1, 1, At, B1); PG8_BAR; PG8_SCHED;
            PG8_LDB(B0, 1, 0); PG8_LDB(B1, 1, 1); PG8_SCHED; PG8_LDA(At, 1, 0); PG8_STAGE_A(0, 1, a2);
            PG8_WAIT_V(8); PG8_WAIT_L(0); PG8_BAR; PG8_MMA(0, 0, At, B0); PG8_MMA(0, 1, At, B1); PG8_BAR; PG8_SCHED;
            PG8_LDA(At, 1, 1); PG8_STAGE(PG8_SB(1, 0), b3, voffB); PG8_STAGE(PG8_SB(1, 1), b3 + bh2, voffB); PG8_STAGE_A(1, 0, a3);
            PG8_WAIT_V(8); PG8_WAIT_L(0); PG8_BAR; PG8_MMA(1, 0, At, B0); PG8_MMA(1, 1, At, B1); PG8_BAR; PG8_SCHED;
        }
        if (wr == 0) PG8_BAR;
        unsigned cdep = 64u; int rt3 = 0;
        if constexpr (FLOW) { unsigned cv; asm volatile("ds_read_b32 %0, %1\n\ts_waitcnt lgkmcnt(0)" : "=v"(cv) : "v"(dslot) : "memory"); cdep = (unsigned)__builtin_amdgcn_readfirstlane(cv);
            const bool d3 = S.dep(ui + 3, rt3);
            if (lane == 0) { if (d3) glds4_sc1(S.cnt + rt3 * 16, dslot); else asm volatile("ds_write_b32 %0, %1" :: "v"(dslot), "v"(64u) : "memory"); } }
        { int l2; asm volatile("v_mbcnt_lo_u32_b32 %0, -1, 0\n\tv_mbcnt_hi_u32_b32 %0, -1, %0" : "=v"(l2)); E(acc, cur, wr, wc, l2 & 15, l2 >> 4); }
        if constexpr (FLOW) {
            if (cur.kind == 0) { if (lane == 0) (void)__hip_atomic_fetch_add(S.cnt + cur.pm * 16, 1u, RLX_AGENT); }
            PG8_DEPSPIN(rtp, cdep); rtp = rt3; }
        if (!has_next) break;
#pragma unroll
        for (int a = 0; a < 2; ++a)
#pragma unroll
            for (int b = 0; b < 2; ++b)
#pragma unroll
                for (int m = 0; m < 4; ++m)
#pragma unroll
                    for (int n = 0; n < 2; ++n) acc[a][b][m][n] = (f32x4){0.f, 0.f, 0.f, 0.f};
        cur = nxt; cA = nA; cB = nB; cbh = nbh; ++ui;
        if (wr == 1) PG8_BAR;
    }
    PG8_WAIT_V(0);
    PG8_BAR;
#undef PG8_SA
#undef PG8_SB
#undef PG8_STAGE
#undef PG8_LDA
#undef PG8_LDB
#undef PG8_MMA
#undef PG8_RDA
#undef PG8_STAGE_A
#undef PG8_RDB
#undef PG8_WAIT_V
#undef PG8_WAIT_L
#undef PG8_BAR
#undef PG8_SCHED
#undef PG8_GIDX
#undef PG8_DEPSPIN
#undef PG8_STAGE_X
}

struct StaticOrder {
    int nM, nN, nwg, G, c; const char* A; const char* B; const LAS int* ix;
    __device__ void init(int M, int N, int G_, int c_, const void* A_, const void* B_) { nM = M / BM; nN = N / BM; nwg = nM * nN; G = G_; c = c_; A = (const char*)A_; B = (const char*)B_; ix = nullptr; }
    __device__ __forceinline__ bool next(int i, UnitD& u) const {
        const long L = (long)i * G + c; if (L >= nwg) return false;
        int wgid = (int)L; { const int q = nwg / 8, r = nwg % 8, xcd = wgid % 8, off = wgid / 8; wgid = (xcd < r ? xcd * (q + 1) : r * (q + 1) + (xcd - r) * q) + off; }
        const int WGM = 4, nig = WGM * nN, gid = wgid / nig, fm = gid * WGM, gsz = (nM - fm) < WGM ? (nM - fm) : WGM;
        u.pm = fm + ((wgid % nig) % gsz); u.pn = (wgid % nig) / gsz; u.e = 0; u.ui = i;
        u.A = A + (size_t)u.pm * (BM * KDIM * 2); u.B = B + (size_t)u.pn * (BM * KDIM * 2); return true;
    }
    __device__ __forceinline__ const LAS int* idx(int) const { return ix; }
};

__device__ __forceinline__ bool moe_unit(int i, int vcu, int NT, int ncol, int& rt, int& pn) {
    const int x = vcu >> 5, u = i * 32 + (vcu & 31), r0 = (x * NT) >> 3, r1 = ((x + 1) * NT) >> 3, rl = u / ncol;
    if (rl >= r1 - r0) return false;
    rt = r0 + rl; pn = u - rl * ncol; return true;
}
struct MoeOrder {
    int G, vcu, ncol, NT; const LAS int* tp; const LAS int* ixt; const char* A; const char* B; size_t bexp, bcol, astride; bool gather;
    __device__ __forceinline__ bool next(int i, UnitD& u) const {
        int rt, pn; if (!moe_unit(i, vcu, NT, ncol, rt, pn)) return false;
        int e = 0;
        for (int j = 1; j < NE; ++j) e += (rt >= tp[j]) ? 1 : 0;
        e = __builtin_amdgcn_readfirstlane(e);
        u.pm = rt; u.pn = pn; u.e = e; u.ui = i;
        u.A = gather ? A : A + (size_t)rt * astride;
        u.B = B + (size_t)e * bexp + (size_t)pn * bcol; return true;
    }
    __device__ __forceinline__ const LAS int* idx(int uord) const { return ixt + uord * 256; }
};

struct MoeFlow {
    int q, n, r0, nr; const LAS int* tp; const LAS int* ixt; const char* ws; unsigned* cnt;
    __device__ __forceinline__ bool next(int i, UnitD& u) const {
        const int L = i * n + q, n5 = nr * 8; int kind, rl, pn;
        if (L < n5) { kind = 0; rl = L >> 3; pn = L & 7; } else { const int L2 = L - n5; if (L2 >= nr * 4) return false; kind = 1; rl = L2 >> 2; pn = L2 & 3; }
        const int rt = r0 + rl; int e = 0;
        for (int j = 1; j < NE; ++j) e += (rt >= tp[j]) ? 1 : 0;
        e = __builtin_amdgcn_readfirstlane(e);
        u.pm = rt; u.pn = pn; u.e = e; u.ui = i; u.kind = kind;
        u.A = ws + (kind ? WS_ACT : WS_HN); u.bh = kind ? 128u * 1024u : 1024u * 1024u;
        u.B = ws + (kind ? WS_W2 + (size_t)e * (1024 * 1024) + (size_t)pn * (256 * 1024) : WS_W1 + (size_t)e * (2048 * 1024) + (size_t)pn * (128 * 1024)); return true;
    }
    __device__ __forceinline__ const LAS int* idx(int uord) const { return ixt + uord * 256; }
    __device__ __forceinline__ bool dep(int i, int& rt) const { const int L2 = i * n + q - nr * 8; rt = r0 + (L2 >> 2); return L2 >= 0 && L2 < nr * 4; }
};

struct EpiQKV {
    bf16_t* O; const float *gqa, *gka, *gqb, *gkb;
    __device__ __forceinline__ void operator()(const f32x4 (&acc)[2][2][4][2], const UnitD& u, int wr, int wc, int fr, int fq) const {
        const int head = 4 * u.pn + wc; const float* g = nullptr; float sc = 1.f;
        if (head < 8) { g = gqa; sc = C2; } else if (head < 10) { g = gka; } else if (head < 12) { g = nullptr; } else if (head < 20) { g = gqb; sc = C2; } else if (head < 28) { g = gkb; }
        f32x4 gv[2][2];
#pragma unroll
        for (int bj = 0; bj < 2; ++bj)
#pragma unroll
            for (int n = 0; n < 2; ++n) gv[bj][n] = g ? *(const f32x4*)(g + 32 * bj + 8 * fq + 4 * n) * sc : (f32x4){1.f, 1.f, 1.f, 1.f};
        const int row0 = u.pm * BM + wr * 64 + fr, col0 = u.pn * BM + wc * 64 + 8 * fq;
#pragma unroll
        for (int ai = 0; ai < 2; ++ai)
#pragma unroll
            for (int m = 0; m < 4; ++m) {
                float rs = 1.f;
                if (g) { float ss = 0.f;
#pragma unroll
                    for (int bj = 0; bj < 2; ++bj)
#pragma unroll
                        for (int n = 0; n < 2; ++n) { const f32x4 v = acc[ai][bj][m][n]; ss += (v[0] * v[0] + v[1] * v[1]) + (v[2] * v[2] + v[3] * v[3]); }
                    ss += __shfl_xor(ss, 16); ss += __shfl_xor(ss, 32);
                    rs = __builtin_amdgcn_rsqf(ss * (1.f / 64.f) + NORM_EPS); }
                bf16_t* rowp = O + (size_t)(row0 + ai * HALF + m * 16) * NPROJ + col0;
#pragma unroll
                for (int bj = 0; bj < 2; ++bj) { const f32x4 v0 = acc[ai][bj][m][0] * rs * gv[bj][0], v1 = acc[ai][bj][m][1] * rs * gv[bj][1];
                    u32x4 w; w.x = cvt_pk_bf16(v0[0], v0[1]); w.y = cvt_pk_bf16(v0[2], v0[3]); w.z = cvt_pk_bf16(v1[0], v1[1]); w.w = cvt_pk_bf16(v1[2], v1[3]);
                    *(u32x4*)(rowp + bj * 32) = w; }
            }
    }
};
struct EpiX1 {
    const float* base; float* out;
    __device__ __forceinline__ void operator()(const f32x4 (&acc)[2][2][4][2], const UnitD& u, int wr, int wc, int fr, int fq) const {
        const int col0 = u.pn * BM + wc * 32 + 4 * fq;
#pragma unroll
        for (int ai = 0; ai < 2; ++ai)
#pragma unroll
            for (int m = 0; m < 4; ++m) { const size_t off = (size_t)(u.pm * BM + ai * HALF + wr * 64 + m * 16 + fr) * DM + col0;
#pragma unroll
                for (int bj = 0; bj < 2; ++bj)
#pragma unroll
                    for (int n = 0; n < 2; ++n) { const f32x4 bs = __builtin_nontemporal_load((const f32x4*)(base + off + bj * HALF + n * 16)); *(f32x4*)(out + off + bj * HALF + n * 16) = bs + acc[ai][bj][m][n]; } }
    }
};
struct EpiAct {
    unsigned char* ACT; const float* b1;
    __device__ __forceinline__ void operator()(const f32x4 (&acc)[2][2][4][2], const UnitD& u, int wr, int wc, int fr, int fq) const {
        const int col0 = u.pn * 128 + wc * 32 + 8 * fq; const float* bg = b1 + (size_t)u.e * 2048 + col0;
        f32x4 bgl[2], bln[2];
#pragma unroll
        for (int n = 0; n < 2; ++n) { bgl[n] = *(const f32x4*)(bg + 4 * n); bln[n] = *(const f32x4*)(bg + 1024 + 4 * n) + 1.0f; }
#pragma unroll
        for (int ai = 0; ai < 2; ++ai)
#pragma unroll
            for (int m = 0; m < 4; ++m) { const int rl = ai * HALF + wr * 64 + m * 16 + fr; const float rs = 1.0f / 64.0f;
                unsigned w[2];
#pragma unroll
                for (int n = 0; n < 2; ++n) { const f32x4 gl = acc[ai][0][m][n] * rs + bgl[n], ln = acc[ai][1][m][n] * rs + bln[n]; float a[4];
#pragma unroll
                    for (int e = 0; e < 4; e += 2) {
                        const f32x2 gg = (f32x2){fminf(gl[e], 7.0f), fminf(gl[e + 1], 7.0f)}, ll = (f32x2){__builtin_amdgcn_fmed3f(ln[e], -6.0f, 8.0f), __builtin_amdgcn_fmed3f(ln[e + 1], -6.0f, 8.0f)};
                        const f32x2 t = gg * (-1.702f * LOG2E); f32x2 den = (f32x2){__builtin_amdgcn_exp2f(t[0]), __builtin_amdgcn_exp2f(t[1])} + 1.0f;
                        const f32x2 rr = (f32x2){__builtin_amdgcn_rcpf(den[0]), __builtin_amdgcn_rcpf(den[1])}; const f32x2 av = (gg * ll) * rr; a[e] = av[0]; a[e + 1] = av[1]; }
                    int p = 0; p = __builtin_amdgcn_cvt_pk_fp8_f32(a[0], a[1], p, false); p = __builtin_amdgcn_cvt_pk_fp8_f32(a[2], a[3], p, true); w[n] = (unsigned)p; }
                *(u32x2*)(ACT + (size_t)(u.pm * BM + rl) * DFF + col0) = (u32x2){w[0], w[1]}; }
    }
};
struct EpiY {
    unsigned char* Y; const float* b2;
    __device__ __forceinline__ void operator()(const f32x4 (&acc)[2][2][4][2], const UnitD& u, int wr, int wc, int fr, int fq) const {
        const int col0 = u.pn * BM + wc * 32 + 8 * fq; const float* bb = b2 + (size_t)u.e * DM + col0;
        f32x4 bv[2][2];
#pragma unroll
        for (int bj = 0; bj < 2; ++bj)
#pragma unroll
            for (int n = 0; n < 2; ++n) bv[bj][n] = *(const f32x4*)(bb + bj * HALF + 4 * n);
#pragma unroll
        for (int ai = 0; ai < 2; ++ai)
#pragma unroll
            for (int m = 0; m < 4; ++m) { unsigned char* rowp = Y + (size_t)(u.pm * BM + ai * HALF + wr * 64 + m * 16 + fr) * DM + col0;
#pragma unroll
                for (int bj = 0; bj < 2; ++bj) { const f32x4 v0 = acc[ai][bj][m][0] * (1.0f / 64.0f) + bv[bj][0], v1 = acc[ai][bj][m][1] * (1.0f / 64.0f) + bv[bj][1];
                    int p0 = 0, p1 = 0; p0 = __builtin_amdgcn_cvt_pk_fp8_f32(v0[0], v0[1], p0, false); p0 = __builtin_amdgcn_cvt_pk_fp8_f32(v0[2], v0[3], p0, true);
                    p1 = __builtin_amdgcn_cvt_pk_fp8_f32(v1[0], v1[1], p1, false); p1 = __builtin_amdgcn_cvt_pk_fp8_f32(v1[2], v1[3], p1, true);
                    *(u32x2*)(rowp + bj * HALF) = (u32x2){(unsigned)p0, (unsigned)p1}; } }
    }
};
struct EpiMoe {
    EpiAct a; EpiY y; unsigned* cnt;
    __device__ __forceinline__ void operator()(const f32x4 (&acc)[2][2][4][2], const UnitD& u, int wr, int wc, int fr, int fq) const {
        if (u.kind == 0) { a(acc, u, wr, wc, fr, fq); asm volatile("s_waitcnt vmcnt(0)" ::: "memory"); }
        else y(acc, u, wr, wc, fr, fq);
    }
};
}

namespace att {
typedef LAS const char* lds_cptr;
typedef short v4i16_t __attribute__((ext_vector_type(4)));
__device__ __forceinline__ int crow(int r, int hi) { return (r & 3) + 8 * (r >> 2) + 4 * hi; }
__device__ __forceinline__ void glds16(const void* gsrc, unsigned lds_dst) { unsigned keep;
    asm volatile("s_mov_b32 %0, m0\n\ts_mov_b32 m0, %2\n\ts_nop 0\n\tglobal_load_lds_dwordx4 %1, off\n\ts_mov_b32 m0, %0" : "=&s"(keep) : "v"(gsrc), "s"(lds_dst) : "memory"); }
__device__ __forceinline__ s16x4 vtr(lds_cptr p) { return __builtin_bit_cast(s16x4, __builtin_amdgcn_ds_read_tr16_b64_v4i16((LAS v4i16_t*)p)); }

struct WU {
    const bf16_t* P;
    int seq0;
    int dil, L, hw;
    int J0u, NTU, sb;
    int U0, toff;
    int qcol, kcol, vcol;
    float slope2, negc, sinkp;
    bf16_t* O; int opitch, ocol;
    float* lout; int lstride, lcol;
};

__device__ __forceinline__ void issue_tile(const WU& w, char* base, int t, int lane) {
    const unsigned lds0 = (unsigned)(uintptr_t)base;
    const int sl_ = w.sb + t; const unsigned kd = (unsigned)__builtin_amdgcn_readfirstlane(lds0 + (sl_ >= ATT_NS ? sl_ - ATT_NS : sl_) * 8192);
#pragma unroll
    for (int i = 0; i < 4; ++i) { const int kl = 8 * i + (lane >> 3); int jk = w.J0u + 32 * t + kl; jk = jk < 0 ? 0 : (jk > w.L - 1 ? w.L - 1 : jk);
        glds16(w.P + (size_t)(w.seq0 + jk * w.dil) * NPROJ + w.kcol + (((lane & 7) ^ ((kl >> 1) & 7)) << 3), kd + i * 1024); }
#pragma unroll
    for (int i = 0; i < 4; ++i) { const int kl = 8 * i + (lane >> 3); int jv = w.J0u + 32 * t + kl; jv = jv < 0 ? 0 : (jv > w.L - 1 ? w.L - 1 : jv);
        glds16(w.P + (size_t)(w.seq0 + jv * w.dil) * NPROJ + w.vcol + (((lane & 7) ^ (((kl >> 1) & 1) << 2)) << 3), kd + 4096 + i * 1024); }
}
__device__ __forceinline__ void load_tiles(const WU& w, char* base, int wave, int lane, int t0, int t1) {
    for (int t = t0 + wave; t < t1; t += 8) { const int jf = w.J0u + 32 * t; if (jf + 31 < 0 || jf >= w.L) continue; issue_tile(w, base, t, lane); }
}
__device__ __forceinline__ void load_q(const WU& w, int lane, bf16x8 (&qr)[4]) {
    const int qtok = w.seq0 + (w.U0 + (lane & 31)) * w.dil;
#pragma unroll
    for (int c = 0; c < 4; ++c) qr[c] = *(const bf16x8*)(w.P + (size_t)qtok * NPROJ + w.qcol + c * 16 + (lane >> 5) * 8);
}
__device__ __forceinline__ void compute_unit(const WU& w, char* base, const bf16x8 (&qr)[4], f32x16 (&o)[2], float& lsum_out) {
    const int lane = threadIdx.x & 63, r32 = lane & 31, hi = lane >> 5;
    const lds_cptr b3 = (lds_cptr)base;
    const int HW = w.hw, NT = (32 + 2 * HW) / 32;
    const int J0 = w.U0 - HW;
    const int klo = (-J0 / 32) > 0 ? (-J0 / 32) : 0;
    const int khi = ((w.L - J0) / 32 - 1) < (NT - 1) ? ((w.L - J0) / 32 - 1) : (NT - 1);
    const bool edge = (J0 < 0) || (w.U0 + 32 + HW > w.L);
    f32x16 negcv;
#pragma unroll
    for (int r = 0; r < 16; ++r) negcv[r] = w.negc;
    o[0] = f32x16{}; o[1] = f32x16{};
    float lsum = 0.f;
    const float lof = fmaxf((float)-HW, (float)-(w.U0 + r32)), hif = fminf((float)HW, (float)(w.L - 1 - w.U0 - r32));
    for (int k = klo; k <= khi; ++k) {
        const int sl0 = w.sb + w.toff + k, sl = sl0 >= ATT_NS ? sl0 - ATT_NS : sl0;
        const lds_cptr kp = b3 + sl * 8192 + r32 * 128;
        bf16x8 kf[4];
#pragma unroll
        for (int c = 0; c < 4; ++c) kf[c] = *(const LAS bf16x8*)(kp + (((2 * c + hi) ^ ((r32 >> 1) & 7)) << 4));
        f32x16 s = __builtin_amdgcn_mfma_f32_32x32x16_bf16(kf[0], qr[0], negcv, 0, 0, 0);
        s = __builtin_amdgcn_mfma_f32_32x32x16_bf16(kf[1], qr[1], s, 0, 0, 0);
        s = __builtin_amdgcn_mfma_f32_32x32x16_bf16(kf[2], qr[2], s, 0, 0, 0);
        s = __builtin_amdgcn_mfma_f32_32x32x16_bf16(kf[3], qr[3], s, 0, 0, 0);
        const float cf = (float)(32 * k - HW + 4 * hi - r32);
        const bool masked = edge || (k == 0) || (k == NT - 1);
        const int R0 = 32 * k - HW;
        if (masked) {
#pragma unroll
            for (int r = 0; r < 16; ++r) { const float rel = cf + (float)((r & 3) + 8 * (r >> 2)); const float x = __builtin_fmaf(-w.slope2, __builtin_fabsf(rel), s[r]);
                const float p = __builtin_amdgcn_exp2f(x); s[r] = (rel >= lof && rel <= hif) ? p : 0.f; }
        } else if (R0 != 0) {
            const float sg = R0 < 0 ? w.slope2 : -w.slope2; const f32x2 cf2 = (f32x2){cf, cf}, sg2 = (f32x2){sg, sg};
#pragma unroll
            for (int r = 0; r < 16; r += 2) { const f32x2 c2 = (f32x2){(float)((r & 3) + 8 * (r >> 2)), (float)(((r + 1) & 3) + 8 * ((r + 1) >> 2))};
                const f32x2 x2 = __builtin_elementwise_fma(sg2, cf2 + c2, (f32x2){s[r], s[r + 1]});
                s[r] = __builtin_amdgcn_exp2f(x2[0]); s[r + 1] = __builtin_amdgcn_exp2f(x2[1]); }
        } else {
#pragma unroll
            for (int r = 0; r < 16; ++r) { const float rel = cf + (float)((r & 3) + 8 * (r >> 2)); const float x = __builtin_fmaf(-w.slope2, __builtin_fabsf(rel), s[r]);
                s[r] = __builtin_amdgcn_exp2f(x); }
        }
        { f32x2 a2 = (f32x2){s[0], s[1]} + (f32x2){s[2], s[3]}, b2 = (f32x2){s[4], s[5]} + (f32x2){s[6], s[7]}, c2 = (f32x2){s[8], s[9]} + (f32x2){s[10], s[11]}, d2 = (f32x2){s[12], s[13]} + (f32x2){s[14], s[15]};
          a2 = (a2 + b2) + (c2 + d2); lsum += a2[0] + a2[1]; }
        u32x4 pw0, pw1;
        pw0.x = cvt_pk_bf16(s[0], s[1]); pw0.y = cvt_pk_bf16(s[2], s[3]); pw0.z = cvt_pk_bf16(s[4], s[5]); pw0.w = cvt_pk_bf16(s[6], s[7]);
        pw1.x = cvt_pk_bf16(s[8], s[9]); pw1.y = cvt_pk_bf16(s[10], s[11]); pw1.z = cvt_pk_bf16(s[12], s[13]); pw1.w = cvt_pk_bf16(s[14], s[15]);
        const int vq = (lane & 15) >> 2, vg = (lane >> 4) & 1, vpp = lane & 3, vqb = (vq >> 1) & 1;
        const lds_cptr vbase = b3 + sl * 8192 + 4096 + (4 * hi + vq) * 128 + (2 * vg + (vpp >> 1)) * 16 + (vpp & 1) * 8;
#pragma unroll
        for (int d0 = 0; d0 < 2; ++d0) {
            const lds_cptr vp = vbase + ((d0 ^ vqb) << 6);
            const s16x4 l0 = vtr(vp), h0 = vtr(vp + 1024), l1 = vtr(vp + 2048), h1 = vtr(vp + 3072);
            const bf16x8 vf0 = (bf16x8){l0[0], l0[1], l0[2], l0[3], h0[0], h0[1], h0[2], h0[3]}, vf1 = (bf16x8){l1[0], l1[1], l1[2], l1[3], h1[0], h1[1], h1[2], h1[3]};
            o[d0] = __builtin_amdgcn_mfma_f32_32x32x16_bf16(__builtin_bit_cast(bf16x8, pw0), vf0, o[d0], 0, 0, 0);
            o[d0] = __builtin_amdgcn_mfma_f32_32x32x16_bf16(__builtin_bit_cast(bf16x8, pw1), vf1, o[d0], 0, 0, 0);
        }
    }
    lsum += __shfl_xor(lsum, 32);
    lsum += w.sinkp;
    lsum_out = lsum;
}
__device__ __forceinline__ void store_unit(const WU& w, const f32x16 (&o)[2], float lsum, LAS bf16_t* stg, LAS float* wsf) {
    const int lane = threadIdx.x & 63, r32 = lane & 31, hi = lane >> 5;
    if (hi == 0) wsf[r32] = lsum;
    LDS_WAIT();
    float rli[16];
#pragma unroll
    for (int r = 0; r < 16; ++r) rli[r] = __builtin_amdgcn_rcpf(wsf[crow(r, hi)]);
#pragma unroll
    for (int j = 0; j < 4; ++j) {
#pragma unroll
        for (int rr = 0; rr < 4; ++rr) { const int r = 4 * j + rr, lrow = rr + 4 * hi; const unsigned pk = cvt_pk_bf16(o[0][r] * rli[r], o[1][r] * rli[r]);
            stg[lrow * 64 + r32] = (bf16_t)(pk & 0xffffu); stg[lrow * 64 + 32 + r32] = (bf16_t)(pk >> 16); }
        LDS_WAIT();
        { const int lrow = lane >> 3, ch = lane & 7; const u32x4 v = *(const LAS u32x4*)(stg + lrow * 64 + ch * 8);
          const int tok = w.seq0 + (w.U0 + 8 * j + lrow) * w.dil; *(u32x4*)(w.O + (size_t)tok * w.opitch + w.ocol + ch * 8) = v; }
        LDS_WAIT();
    }
    if (w.lout && hi == 0) { const int qtok = w.seq0 + (w.U0 + r32) * w.dil; w.lout[(size_t)qtok * w.lstride + w.lcol] = lsum; }
    LDS_WAIT();
}
}

#define XB_TMO      128
#define XB_XCNT(j)  (256  + 64 * (j))
#define XB_XSUB(j)  (1280 + 64 * (j))
#define XB_XGEN(j)  (2304 + 64 * (j))
#define XB_TOP      3328
#define XB_TOPGEN   3392
#define XB_SPIN_CAP (1u << 20)
__device__ __forceinline__ unsigned xb_ld(unsigned* p)              { return __hip_atomic_load(p, __ATOMIC_RELAXED, __HIP_MEMORY_SCOPE_AGENT); }
__device__ __forceinline__ unsigned xb_add(unsigned* p, unsigned v) { return __hip_atomic_fetch_add(p, v, __ATOMIC_RELAXED, __HIP_MEMORY_SCOPE_AGENT); }
__device__ __forceinline__ unsigned xb_xcc_id() { return (unsigned)__builtin_amdgcn_s_getreg((3 << 11) | 20) & 0xFu; }
#define XB_SPIN(cond, bar) do { unsigned _sp = 0; while (cond) { __builtin_amdgcn_s_sleep(1); \
    if ((++_sp & 255u) == 0u) { if (xb_ld(&(bar)[XB_TMO])) break; if (_sp > XB_SPIN_CAP) { atomicAdd(&(bar)[XB_TMO], 1u); break; } } } } while (0)
struct XcdBarrier { unsigned* bar; unsigned x; volatile LAS unsigned* st; };
__device__ __forceinline__ XcdBarrier xcd_barrier_post(unsigned* bar, volatile LAS unsigned* st) {
    XcdBarrier b; b.bar = bar; b.x = xb_xcc_id(); b.st = st;
    if (threadIdx.x == 0) { st[2] = xb_add(&bar[XB_XCNT(b.x)], 1u); st[3] = b.x; }
    return b;
}
__device__ __forceinline__ void xcd_barrier_complete(unsigned* bar, unsigned x, unsigned& nloc, unsigned& nx) {
    const unsigned G = gridDim.x * gridDim.y * gridDim.z;
    unsigned sum, cnt, mine, sp = 0u;
    for (;;) {
        sum = 0u; cnt = 0u; mine = 0u;
#pragma unroll
        for (unsigned j = 0; j < 16; ++j) { const unsigned c = xb_ld(&bar[XB_XCNT(j)]); sum += c; cnt += (c > 0u) ? 1u : 0u; mine = (j == x) ? c : mine; }
        if (sum == G) break;
        __builtin_amdgcn_s_sleep(1);
        if ((++sp & 255u) == 0u) { if (xb_ld(&bar[XB_TMO])) break; if (sp > XB_SPIN_CAP) { atomicAdd(&bar[XB_TMO], 1u); break; } }
    }
    nloc = mine > 0u ? mine : 1u; nx = cnt > 0u ? cnt : 1u;
}
__device__ __forceinline__ void xcd_barrier(const XcdBarrier& b) {
    asm volatile("s_waitcnt vmcnt(0)" ::: "memory");
    __syncthreads();
    if (threadIdx.x == 0) {
        unsigned* bar = b.bar;
        __builtin_amdgcn_s_waitcnt(0);
        unsigned nloc = b.st[0], nx = b.st[1];
        if (nloc == 0u) { xcd_barrier_complete(bar, b.x, nloc, nx); b.st[0] = nloc; b.st[1] = nx; }
        const unsigned old = xb_add(&bar[XB_XSUB(b.x)], 1u);
        const unsigned gen = old / nloc;
        if (old + 1u == (gen + 1u) * nloc) {
            __builtin_amdgcn_fence(__ATOMIC_RELEASE, "agent");
            asm volatile("s_waitcnt vmcnt(0)" ::: "memory");
            const unsigned og = xb_add(&bar[XB_TOP], 1u);
            const unsigned tg = og / nx;
            if (og + 1u == (tg + 1u) * nx) xb_add(&bar[XB_TOPGEN], 1u);
            else XB_SPIN(xb_ld(&bar[XB_TOPGEN]) == tg, bar);
            __builtin_amdgcn_fence(__ATOMIC_ACQUIRE, "agent");
            xb_add(&bar[XB_XGEN(b.x)], 1u);
            asm volatile("s_waitcnt vmcnt(0)" ::: "memory");
        } else {
            XB_SPIN(xb_ld(&bar[XB_XGEN(b.x)]) == gen, bar);
            __builtin_amdgcn_fence(__ATOMIC_ACQUIRE, "agent");
            asm volatile("s_waitcnt vmcnt(0)" ::: "memory");
        }
    }
    __syncthreads();
}

__device__ __forceinline__ void p0_transpose_item(const float* W, int K, int N, bf16_t* WT, LAS unsigned* scr, int kb, int nb, int lane) {
    const int k0 = 64 * kb, n0 = 64 * nb; const float* src = W + (size_t)k0 * N + n0; const int kp = lane >> 4, nc = (lane & 15) * 4;
#pragma unroll
    for (int j = 0; j < 8; ++j) { const int kk = 8 * j + 2 * kp;
        const f32x4 a = __builtin_nontemporal_load((const GAS f32x4*)(src + (size_t)kk * N + nc)), b = __builtin_nontemporal_load((const GAS f32x4*)(src + (size_t)(kk + 1) * N + nc));
        scr[(nc + 0) * 33 + (kk >> 1)] = pk2(a[0], b[0]); scr[(nc + 1) * 33 + (kk >> 1)] = pk2(a[1], b[1]);
        scr[(nc + 2) * 33 + (kk >> 1)] = pk2(a[2], b[2]); scr[(nc + 3) * 33 + (kk >> 1)] = pk2(a[3], b[3]); }
    LDS_WAIT(); asm volatile("" ::: "memory");
    const int c8 = lane & 7;
#pragma unroll
    for (int i = 0; i < 8; ++i) { const int n = (lane >> 3) + 8 * i; const LAS unsigned* s = scr + n * 33 + 4 * c8;
        u32x4 o; o.x = s[0]; o.y = s[1]; o.z = s[2]; o.w = s[3];
        *(GAS u32x4*)(WT + (size_t)(n0 + n) * K + k0 + 8 * c8) = o; }
    LDS_WAIT(); asm volatile("" ::: "memory");
}

__device__ __forceinline__ void p0_transpose_item_fp8(const float* W, int K, int N, unsigned char* WT, LAS unsigned* scr, int kb, int nb, int lane) {
    const int k0 = 128 * kb, n0 = 64 * nb; const float* src = W + (size_t)k0 * N + n0; const int nc = (lane & 15) * 4;
    LAS unsigned char* T = (LAS unsigned char*)scr;
    f32x4 a[2][16];
#pragma unroll
    for (int j = 0; j < 2; ++j)
#pragma unroll
        for (int q = 0; q < 16; ++q) a[j][q] = __builtin_nontemporal_load((const GAS f32x4*)(src + (size_t)(16 * (4 * j + (lane >> 4)) + q) * N + nc));
#pragma unroll
    for (int j = 0; j < 2; ++j) {
        const int k16 = 4 * j + (lane >> 4);
#pragma unroll
        for (int c = 0; c < 4; ++c) { unsigned w[4];
#pragma unroll
            for (int d = 0; d < 4; ++d) { int p = 0; p = __builtin_amdgcn_cvt_pk_fp8_f32(a[j][4 * d][c] * 64.f, a[j][4 * d + 1][c] * 64.f, p, false); p = __builtin_amdgcn_cvt_pk_fp8_f32(a[j][4 * d + 2][c] * 64.f, a[j][4 * d + 3][c] * 64.f, p, true); w[d] = (unsigned)p; }
            const int n = nc + c; *(LAS u32x4*)(T + n * 128 + ((k16 ^ ((n >> 2) & 7)) << 4)) = (u32x4){w[0], w[1], w[2], w[3]}; }
    }
    LDS_WAIT(); asm volatile("" ::: "memory");
    const int c8 = lane & 7;
#pragma unroll
    for (int i = 0; i < 8; ++i) { const int n = (lane >> 3) + 8 * i; const u32x4 o = *(const LAS u32x4*)(T + n * 128 + ((c8 ^ ((n >> 2) & 7)) << 4));
        __builtin_nontemporal_store(o, (GAS u32x4*)(WT + (size_t)(n0 + n) * K + k0 + 16 * c8)); }
    LDS_WAIT(); asm volatile("" ::: "memory");
}

constexpr int W_ITEMS = 8192 + 4096;
constexpr int P1_ITEMS = 11648;
__device__ __forceinline__ void conv_w_item(int t, const float* w1, const float* w2, unsigned char* W1T, unsigned char* W2T, LAS unsigned* scr, int lane) {
    if (t < 8192) { const int e = t >> 8, q = t & 255; p0_transpose_item_fp8(w1 + (size_t)e * 1024 * 2048, 1024, 2048, W1T + (size_t)e * 2048 * 1024, scr, q >> 5, q & 31, lane); }
    else { const int r = t - 8192, e = r >> 7, q = r & 127; p0_transpose_item_fp8(w2 + (size_t)e * 1024 * 1024, 1024, 1024, W2T + (size_t)e * 1024 * 1024, scr, q >> 4, q & 15, lane); }
}

struct Args { const float* in[16]; float* out; unsigned char* ws; };

__global__ void __launch_bounds__(512, 2) hymba_fwd(Args args) {
    extern __shared__ __attribute__((aligned(16))) unsigned char lds[];
    LAS unsigned char* L3 = (LAS unsigned char*)lds;
    const int tid = threadIdx.x, lane = tid & 63, wave = __builtin_amdgcn_readfirstlane(tid >> 6);
    const int G = gridDim.x; const int bx = blockIdx.x; const int vcu = (G % 8 == 0) ? (bx % 8) * (G / 8) + bx / 8 : bx;
    unsigned* ctl = (unsigned*)(args.ws + WS_CTL);
#define WSP(T, off) ((T*)(args.ws + (off)))
    for (int u = tid; u < (LDS_BYTES - RING_BYTES) / 4; u += 512) ((LAS unsigned*)(L3 + RING_BYTES))[u] = 0u;
    __syncthreads();
    XcdBarrier bar = xcd_barrier_post(ctl + CW_BAR, (volatile LAS unsigned*)(L3 + XT_MISC));
#define GRID_BAR() xcd_barrier(bar)
    const int gw = vcu * 8 + wave, NGW = G * 8;

    {
        LAS unsigned* scr = (LAS unsigned*)(L3 + wave * 16384);
        const float* x = args.in[0]; const float* attn_g = args.in[1]; const float* w_in = args.in[2]; const float* w_out = args.in[8]; const float* w_router = args.in[10]; const float* w1 = args.in[12]; const float* w2 = args.in[14];
        bf16_t* WIN = WSP(bf16_t, WS_WIN); bf16_t* WOUT = WSP(bf16_t, WS_WOUT); bf16_t* WRH = WSP(bf16_t, WS_WRH); bf16_t* WRL = WSP(bf16_t, WS_WRL); unsigned char* W1T = WSP(unsigned char, WS_W1); unsigned char* W2T = WSP(unsigned char, WS_W2); bf16_t* XN = WSP(bf16_t, WS_XN);
        constexpr int I_IN = 16 * 36, I_OUT = 16 * 16, NITEMS = I_IN + I_OUT + (W_ITEMS - P1_ITEMS);
        for (int it = gw; it < NITEMS; it += NGW) {
            int r = it;
            if (r < I_IN) { p0_transpose_item(w_in, 1024, NPROJ, WIN, scr, r / 36, r % 36, lane); continue; } r -= I_IN;
            if (r < I_OUT) { p0_transpose_item(w_out, 1024, 1024, WOUT, scr, r / 16, r % 16, lane); continue; } r -= I_OUT;
            conv_w_item(P1_ITEMS + r, w1, w2, W1T, W2T, scr, lane);
        }
        for (int m = gw; m < MTOK; m += 2 * NGW) {
            const int m2 = m + NGW;
            const GAS f32x4* xr = (const GAS f32x4*)(x + (size_t)m * DM) + lane; const GAS f32x4* xr2 = (const GAS f32x4*)(x + (size_t)m2 * DM) + lane; const GAS f32x4* gr = (const GAS f32x4*)attn_g + lane;
            f32x4 v[4], v2[4]; float s = 0.f, s2 = 0.f;
#pragma unroll
            for (int j = 0; j < 4; ++j) { v[j] = __builtin_nontemporal_load(xr + 64 * j); v2[j] = __builtin_nontemporal_load(xr2 + 64 * j); }
#pragma unroll
            for (int j = 0; j < 4; ++j) { s += (v[j][0] * v[j][0] + v[j][1] * v[j][1]) + (v[j][2] * v[j][2] + v[j][3] * v[j][3]); s2 += (v2[j][0] * v2[j][0] + v2[j][1] * v2[j][1]) + (v2[j][2] * v2[j][2] + v2[j][3] * v2[j][3]); }
            const float rstd = __builtin_amdgcn_rsqf(wave_sum(s) * (1.f / DM) + NORM_EPS), rstd2 = __builtin_amdgcn_rsqf(wave_sum(s2) * (1.f / DM) + NORM_EPS);
            GAS u32x2* o8 = (GAS u32x2*)(XN + (size_t)m * DM) + lane; GAS u32x2* o82 = (GAS u32x2*)(XN + (size_t)m2 * DM) + lane;
#pragma unroll
            for (int j = 0; j < 4; ++j) { const f32x4 g = gr[64 * j]; u32x2 o; o.x = pk2(v[j][0] * rstd * g[0], v[j][1] * rstd * g[1]); o.y = pk2(v[j][2] * rstd * g[2], v[j][3] * rstd * g[3]); o8[64 * j] = o;
                u32x2 o2; o2.x = pk2(v2[j][0] * rstd2 * g[0], v2[j][1] * rstd2 * g[1]); o2.y = pk2(v2[j][2] * rstd2 * g[2], v2[j][3] * rstd2 * g[3]); o82[64 * j] = o2; }
        }
        for (int i = vcu * 512 + tid; i < NE * 1024; i += G * 512) { const int e = i >> 10, k = i & 1023; const float wv = w_router[(size_t)k * NE + e]; const unsigned h = f2bf(wv);
            WRH[i] = (bf16_t)h; WRL[i] = (bf16_t)f2bf(wv - bf2f(h)); }
    }
    GRID_BAR();


    {
        const int q8 = bx >> 3, q16 = q8 & 15;
        if (q16 >= 9) {
            LAS unsigned* scr = (LAS unsigned*)(L3 + wave * 16384);
            const int cw = ((((q8 >> 4) * 7 + (q16 - 9)) * 8 + (bx & 7)) * 8) + wave;
            for (int t = cw; t < P1_ITEMS; t += 896) conv_w_item(t, args.in[12], args.in[14], WSP(unsigned char, WS_W1), WSP(unsigned char, WS_W2), scr, lane);
        } else {
            pg8::StaticOrder S; S.init(MTOK, NPROJ, 144, ((q8 >> 4) * 9 + q16) * 8 + (bx & 7), WSP(bf16_t, WS_XN), WSP(bf16_t, WS_WIN));
            pg8::EpiQKV E{WSP(bf16_t, WS_QKV), args.in[3], args.in[4], args.in[6], args.in[7]};
            pg8::gemm_phase<pg8::EpiQKV, pg8::StaticOrder, 2, false, false>(L3, S, E, 32u * 1024u * 2u);
        }
    }
    GRID_BAR();


    {
        const float* a_qg = args.in[3]; const float* a_kg = args.in[4]; const float* a_sinks = args.in[5]; const float* b_qg = args.in[6]; const float* b_kg = args.in[7];
        bf16_t* QKV = WSP(bf16_t, WS_QKV); bf16_t* OB = WSP(bf16_t, WS_OB); bf16_t* ATT = WSP(bf16_t, WS_ATT); float* LB = WSP(float, WS_LB);
        float ga = fabsf(a_qg[lane]), gb = fabsf(a_kg[lane]), gc = fabsf(b_qg[lane]), gd = fabsf(b_kg[lane]);
        ga = wave_max(ga); gb = wave_max(gb); gc = wave_max(gc); gd = wave_max(gd);
        const float boundA = 8.0f * LOG2E * ga * gb + 0.25f, boundB = 8.0f * LOG2E * gc * gd + 0.25f;
        LAS bf16_t* stg = (LAS bf16_t*)(L3 + ATT_STG + wave * 1024);
        LAS float* wsf = (LAS float*)(L3 + ATT_WSF + wave * 128);
        auto mk = [&](int ui, att::WU& w) {
            w.P = QKV;
            if (ui < 2) {
                const int ua = vcu * 2 + ui, b = ua >> 7, kvh = (ua >> 6) & 1, qb = ua & 63, head = kvh * 4 + (wave >> 1);
                w.seq0 = b * SEQ; w.dil = 1; w.L = SEQ; w.hw = 128; w.J0u = qb * 64 - 128; w.NTU = 10; w.U0 = qb * 64 + 32 * (wave & 1); w.toff = wave & 1;
                w.qcol = COL_QA + head * 64; w.kcol = COL_KA + kvh * 64; w.vcol = COL_VA + kvh * 64;
                w.slope2 = exp2f(-0.5f * (float)(head + 1)) * LOG2E; w.negc = -boundA; w.sinkp = exp2f(a_sinks[head] * LOG2E - boundA);
                w.O = ATT; w.opitch = DM; w.ocol = head * 64; w.lout = nullptr; w.lstride = 0; w.lcol = 0;
            } else {
                const int ub = vcu * 6 + (ui - 2), b = ub / 384, hb = (ub / 48) & 7, idx = ub % 48, br = idx >> 4, sub = idx & 15;
                int rho, qb;
                if (br == 0) { w.dil = 1; rho = 0; qb = sub; } else if (br == 1) { w.dil = 4; rho = sub >> 2; qb = sub & 3; } else { w.dil = 16; rho = sub; qb = 0; }
                w.seq0 = b * SEQ + rho; w.L = SEQ / w.dil; w.hw = 64; w.J0u = qb * 256 - 64; w.NTU = 12; w.U0 = qb * 256 + 32 * wave; w.toff = wave;
                w.qcol = COL_QB + hb * 64; w.kcol = COL_KB + hb * 64; w.vcol = COL_VB + hb * 64;
                w.slope2 = exp2f(-0.5f * (float)(8 + hb + 1)) * (float)w.dil * LOG2E; w.negc = -boundB; w.sinkp = 0.f;
                w.O = OB + (size_t)br * MTOK * 512; w.opitch = 512; w.ocol = hb * 64; w.lout = LB + (size_t)br * MTOK * 8; w.lstride = 8; w.lcol = hb;
            }
        };
        int sb = 0; bf16x8 qr[4];
        { att::WU w0; mk(0, w0); w0.sb = 0; att::load_q(w0, lane, qr); att::load_tiles(w0, (char*)lds, wave, lane, 0, w0.NTU); }
        for (int ui = 0; ui < 8; ++ui) {
            att::WU w; mk(ui, w); w.sb = sb;
            const int sbn = (sb + w.NTU) >= ATT_NS ? sb + w.NTU - ATT_NS : sb + w.NTU;
            asm volatile("s_waitcnt vmcnt(0)" ::: "memory");
            __builtin_amdgcn_s_barrier();
            bf16x8 qn[4] = {qr[0], qr[1], qr[2], qr[3]}; int pf = 0; att::WU n;
            if (ui < 7) { mk(ui + 1, n); n.sb = sbn; pf = (ATT_NS - w.NTU) < n.NTU ? (ATT_NS - w.NTU) : n.NTU;
                att::load_q(n, lane, qn); att::load_tiles(n, (char*)lds, wave, lane, 0, pf); }
            f32x16 o[2]; float lsum;
            att::compute_unit(w, (char*)lds, qr, o, lsum);
            att::store_unit(w, o, lsum, stg, wsf);
            LDS_WAIT();
            __builtin_amdgcn_s_barrier();
            if (ui < 7) att::load_tiles(n, (char*)lds, wave, lane, pf, n.NTU);
#pragma unroll
            for (int c = 0; c < 4; ++c) qr[c] = qn[c];
            sb = sbn;
        }
        asm volatile("s_waitcnt vmcnt(0)" ::: "memory");
        __syncthreads();
    }
    GRID_BAR();
    {
        bf16_t* OB = WSP(bf16_t, WS_OB); bf16_t* ATT = WSP(bf16_t, WS_ATT); float* LB = WSP(float, WS_LB);
        for (int it = vcu * 512 + tid; it < MTOK * 64; it += G * 512) {
            const int tok = it >> 6, hb = (it >> 3) & 7, ch = it & 7;
            float l[3]; u32x4 ov[3];
#pragma unroll
            for (int br = 0; br < 3; ++br) { l[br] = LB[(size_t)br * MTOK * 8 + (size_t)tok * 8 + hb]; ov[br] = __builtin_nontemporal_load((const u32x4*)(OB + (size_t)br * MTOK * 512 + (size_t)tok * 512 + hb * 64 + ch * 8)); }
            const float inv = 1.0f / (l[0] + l[1] + l[2]); const float w0 = l[0] * inv, w1_ = l[1] * inv, w2_ = l[2] * inv;
            unsigned ow[4];
#pragma unroll
            for (int q = 0; q < 4; ++q) { const unsigned a = ov[0][q], bq = ov[1][q], c = ov[2][q];
                const float lo = w0 * bf2f(a & 0xffffu) + w1_ * bf2f(bq & 0xffffu) + w2_ * bf2f(c & 0xffffu);
                const float hi = w0 * bf2f(a >> 16) + w1_ * bf2f(bq >> 16) + w2_ * bf2f(c >> 16); ow[q] = pk2(lo, hi); }
            *(u32x4*)(ATT + (size_t)tok * DM + 512 + hb * 64 + ch * 8) = (u32x4){ow[0], ow[1], ow[2], ow[3]};
        }
    }
    GRID_BAR();

    {
        pg8::StaticOrder S; S.init(MTOK, DM, G, bx, WSP(bf16_t, WS_ATT), WSP(bf16_t, WS_WOUT));
        pg8::EpiX1 E{args.in[0], WSP(float, WS_X1)};
        pg8::gemm_phase<pg8::EpiX1, pg8::StaticOrder, 0, false, false>(L3, S, E, 128u * 1024u * 2u);
    }
    GRID_BAR();


    {
        LAS int* hist = (LAS int*)(L3 + XT_HIST); LAS int* hbase = (LAS int*)(L3 + XT_BASE);
        const float* ffn_g = args.in[9]; const float* b_router = args.in[11]; const float* out = WSP(float, WS_X1);
        bf16_t* WRH = WSP(bf16_t, WS_WRH); bf16_t* WRL = WSP(bf16_t, WS_WRL); unsigned char* HN = WSP(unsigned char, WS_HN);
        float* RT = WSP(float, WS_RT); int* TOPE = WSP(int, WS_TOPE); int* TOPS = WSP(int, WS_TOPS); float* GATE = WSP(float, WS_GATE); int* LIST = WSP(int, WS_LIST);
        if (tid < 32) hist[tid] = 0;
        __syncthreads();
        const int r32 = lane & 31, hi = lane >> 5, grp = wave >> 2, kq = wave & 3;
        int te[4] = {0, 0, 0, 0}, tsl[4] = {0, 0, 0, 0}; float tg[4] = {0.f, 0.f, 0.f, 0.f};
        const int tok = vcu * 64 + grp * 32 + r32;
        LAS float* rstd_l = (LAS float*)(L3 + 101376);
        { f32x4 pa[8][4];
#pragma unroll
          for (int rr = 0; rr < 8; ++rr)
#pragma unroll
            for (int j = 0; j < 4; ++j) pa[rr][j] = ((const GAS f32x4*)(out + (size_t)(vcu * 64 + wave * 8 + rr) * DM) + lane)[64 * j];
#pragma unroll
          for (int rr = 0; rr < 8; ++rr) { float sq = 0.f;
#pragma unroll
            for (int j = 0; j < 4; ++j) { const f32x4 v = pa[rr][j]; sq += (v[0] * v[0] + v[1] * v[1]) + (v[2] * v[2] + v[3] * v[3]); }
            sq = wave_sum(sq); if (lane == 0) rstd_l[wave * 8 + rr] = __builtin_amdgcn_rsqf(sq * (1.f / DM) + NORM_EPS); } }
        __syncthreads();
        f32x16 acc = f32x16{};
        {
            constexpr int PITCH = 528;
            LAS unsigned char* XH = L3; LAS unsigned char* XL = L3 + 33792; LAS unsigned char* WH = L3 + 67584; LAS unsigned char* WL = L3 + 84480;
            f32x4 g4, xv[8]; u32x4 wv[4];
#define P4_LOAD(c) do { g4 = *(const f32x4*)(ffn_g + 256 * (c) + 4 * lane); \
                _Pragma("unroll") for (int rr = 0; rr < 8; ++rr) xv[rr] = *(const GAS f32x4*)(out + (size_t)(vcu * 64 + wave * 8 + rr) * DM + 256 * (c) + 4 * lane); \
                _Pragma("unroll") for (int i = 0; i < 2; ++i) { const int e = 4 * wave + 2 * i + (lane >> 5); wv[i] = *(const GAS u32x4*)(WRH + (size_t)e * 1024 + 256 * (c) + 8 * (lane & 31)); wv[2 + i] = *(const GAS u32x4*)(WRL + (size_t)e * 1024 + 256 * (c) + 8 * (lane & 31)); } } while (0)
            P4_LOAD(0);
            for (int c = 0; c < 4; ++c) {
#pragma unroll
                for (int rr = 0; rr < 8; ++rr) { const int row = wave * 8 + rr; const float rs = rstd_l[row];
                    const float v0 = xv[rr][0] * g4[0] * rs, v1 = xv[rr][1] * g4[1] * rs, v2 = xv[rr][2] * g4[2] * rs, v3 = xv[rr][3] * g4[3] * rs;
                    int p = 0; p = __builtin_amdgcn_cvt_pk_fp8_f32(v0, v1, p, false); p = __builtin_amdgcn_cvt_pk_fp8_f32(v2, v3, p, true);
                    *(GAS unsigned*)(HN + (size_t)(vcu * 64 + row) * DM + 256 * c + 4 * lane) = (unsigned)p;
                    const unsigned h01 = pk2(v0, v1), h23 = pk2(v2, v3);
                    *(LAS u32x2*)(XH + row * PITCH + 8 * lane) = (u32x2){h01, h23};
                    *(LAS u32x2*)(XL + row * PITCH + 8 * lane) = (u32x2){pk2(v0 - __builtin_bit_cast(float, h01 << 16), v1 - __builtin_bit_cast(float, h01 & 0xffff0000u)),
                                                                         pk2(v2 - __builtin_bit_cast(float, h23 << 16), v3 - __builtin_bit_cast(float, h23 & 0xffff0000u))}; }
#pragma unroll
                for (int i = 0; i < 2; ++i) { const int e = 4 * wave + 2 * i + (lane >> 5); *(LAS u32x4*)(WH + e * PITCH + 16 * (lane & 31)) = wv[i]; *(LAS u32x4*)(WL + e * PITCH + 16 * (lane & 31)) = wv[2 + i]; }
                __syncthreads();
                if (c < 3) P4_LOAD(c + 1);
#pragma unroll
                for (int ss = 0; ss < 4; ++ss) { const int ko = (16 * (kq * 4 + ss) + 8 * hi) * 2;
                    const bf16x8 xh = *(const LAS bf16x8*)(XH + (grp * 32 + r32) * PITCH + ko), xl = *(const LAS bf16x8*)(XL + (grp * 32 + r32) * PITCH + ko);
                    const bf16x8 wa = *(const LAS bf16x8*)(WH + r32 * PITCH + ko), wb = *(const LAS bf16x8*)(WL + r32 * PITCH + ko);
                    acc = __builtin_amdgcn_mfma_f32_32x32x16_bf16(wa, xh, acc, 0, 0, 0);
                    acc = __builtin_amdgcn_mfma_f32_32x32x16_bf16(wa, xl, acc, 0, 0, 0);
                    acc = __builtin_amdgcn_mfma_f32_32x32x16_bf16(wb, xh, acc, 0, 0, 0); }
                __syncthreads();
            }
#undef P4_LOAD
        }
        LAS float* red = (LAS float*)L3;
#pragma unroll
        for (int r = 0; r < 16; ++r) red[(wave * 17 + r) * 64 + lane] = acc[r];
        __syncthreads();
        if (kq == 0) {
#pragma unroll
            for (int q = 1; q < 4; ++q) {
#pragma unroll
                for (int r = 0; r < 16; ++r) acc[r] += red[((wave + q) * 17 + r) * 64 + lane]; }
            float lg[32];
#pragma unroll
            for (int r = 0; r < 16; ++r) { const float own = acc[r], oth = __shfl_xor(own, 32); const int e0 = (r & 3) + 8 * (r >> 2);
                const float v0 = hi ? oth : own, v1 = hi ? own : oth;
                lg[e0] = v0 + b_router[e0]; lg[e0 + 4] = v1 + b_router[e0 + 4]; }
            float tv[4];
#pragma unroll
            for (int kk = 0; kk < 4; ++kk) { float best = -INFINITY; int bi = 0;
#pragma unroll
                for (int e = 0; e < 32; ++e) { if (lg[e] > best) { best = lg[e]; bi = e; } }
#pragma unroll
                for (int e = 0; e < 32; ++e) { if (e == bi) lg[e] = -INFINITY; }
                tv[kk] = best; te[kk] = bi; }
            float ex[4], sum = 0.f;
#pragma unroll
            for (int kk = 0; kk < 4; ++kk) { ex[kk] = __expf(tv[kk] - tv[0]); sum += ex[kk]; }
#pragma unroll
            for (int kk = 0; kk < 4; ++kk) tg[kk] = ex[kk] / sum;
            if (hi == 0) {
#pragma unroll
                for (int kk = 0; kk < 4; ++kk) tsl[kk] = __hip_atomic_fetch_add(&hist[te[kk]], 1, __ATOMIC_RELAXED, __HIP_MEMORY_SCOPE_WORKGROUP);
            }
        }
        __syncthreads();
        if (tid < 32) hbase[tid] = (int)atomicAdd(ctl + CW_CNT + 64 * tid, (unsigned)hist[tid]);
        __syncthreads();
        if (kq == 0 && hi == 0) {
#pragma unroll
            for (int kk = 0; kk < 4; ++kk) { const int e = te[kk], slot = hbase[e] + tsl[kk]; LIST[(size_t)e * LISTCAP + slot] = tok; TOPE[tok * 4 + kk] = e; TOPS[tok * 4 + kk] = slot; GATE[tok * 4 + kk] = tg[kk]; }
        }
    }
    GRID_BAR();


    LAS int* tp = (LAS int*)(L3 + XT_TP); LAS int* cntl = (LAS int*)(L3 + XT_CNT); LAS int* ixt = (LAS int*)(L3 + XT_IDX);
    if (tid < NE) cntl[tid] = (int)__hip_atomic_load(ctl + CW_CNT + 64 * tid, RLX_AGENT);
    __syncthreads();
    if (tid == 0) { int acc_t = 0; for (int e = 0; e < NE; ++e) { tp[e] = acc_t; acc_t += (cntl[e] + 255) >> 8; } tp[NE] = acc_t; }
    __syncthreads();
    const int NTILES = __builtin_amdgcn_readfirstlane(tp[NE]);
    LAS int* xc = (LAS int*)(L3 + XT_MISC + 16);
    if (tid < 16) xc[tid] = (int)xb_ld(ctl + CW_BAR + XB_XCNT(tid));
    __syncthreads();
    int fq_, fn_, fr0_, fnr_;
    { const int myx = ((volatile LAS int*)(L3 + XT_MISC))[3]; int P = 0, n = 1;
      for (int j = 0; j < 16; ++j) { const int c = xc[j]; P += (j < myx) ? c : 0; n = (j == myx) ? c : n; }
      fq_ = __builtin_amdgcn_readfirstlane(((volatile LAS int*)(L3 + XT_MISC))[2]); fn_ = __builtin_amdgcn_readfirstlane(n); P = __builtin_amdgcn_readfirstlane(P);
      fr0_ = (NTILES * P) / G; fnr_ = (NTILES * (P + fn_)) / G - fr0_; }
    {
        int* LISTp = WSP(int, WS_LIST);
#pragma unroll
        for (int j = 0; j < 12; ++j) { const int idx = tid + 512 * j, i = idx >> 8, r = idx & 255; const int L = i * fn_ + fq_, L2 = L - fnr_ * 8;
            if (L2 < 0) { const int rt = fr0_ + (L >> 3); int e = 0; for (int q = 1; q < NE; ++q) e += (rt >= tp[q]) ? 1 : 0;
                const int n = cntl[e]; int sl = (rt - tp[e]) * 256 + r; sl = sl < n ? sl : n - 1; ixt[idx] = LISTp[(size_t)e * LISTCAP + sl]; }
            else if (L2 < fnr_ * 4) ixt[idx] = (fr0_ + (L2 >> 2)) * 256 + r; }
    }
    __syncthreads();

    {
        pg8::MoeFlow S; S.q = fq_; S.n = fn_; S.r0 = fr0_; S.nr = fnr_; S.tp = tp; S.ixt = ixt; S.ws = (const char*)args.ws; S.cnt = ctl + CW_RTC;
        pg8::EpiMoe E{pg8::EpiAct{WSP(unsigned char, WS_ACT), args.in[13]}, pg8::EpiY{WSP(unsigned char, WS_Y), args.in[15]}, ctl + CW_RTC};
        pg8::gemm_phase<pg8::EpiMoe, pg8::MoeFlow, 1, true, true, true>(L3, S, E, 0u);
    }
    GRID_BAR();


    { float* out = args.out; int* TOPE = WSP(int, WS_TOPE); int* TOPS = WSP(int, WS_TOPS); float* GATE = WSP(float, WS_GATE); unsigned char* YB = WSP(unsigned char, WS_Y);
    for (int m0 = gw * 8; m0 < MTOK; m0 += NGW * 8) {
        int rowv = 0; float gatev = 0.f;
        if (lane < 32) { const int e = TOPE[m0 * 4 + lane], slot = TOPS[m0 * 4 + lane]; gatev = GATE[m0 * 4 + lane]; rowv = tp[e] * 256 + slot; }
#pragma unroll 2
        for (int t = 0; t < 8; ++t) {
            GAS f32x4* orow = (GAS f32x4*)(out + (size_t)(m0 + t) * DM) + lane; const GAS f32x4* xrow = (const GAS f32x4*)(WSP(float, WS_X1) + (size_t)(m0 + t) * DM) + lane;
            f32x4 v[4]; unsigned y[4][4]; float gt[4];
#pragma unroll
            for (int kk = 0; kk < 4; ++kk) { const int row = __shfl(rowv, t * 4 + kk); gt[kk] = __shfl(gatev, t * 4 + kk);
                const GAS unsigned* yr = (const GAS unsigned*)(YB + (size_t)row * DM) + lane;
#pragma unroll
                for (int j = 0; j < 4; ++j) y[kk][j] = __builtin_nontemporal_load(yr + 64 * j); }
#pragma unroll
            for (int j = 0; j < 4; ++j) v[j] = __builtin_nontemporal_load(xrow + 64 * j);
#pragma unroll
            for (int kk = 0; kk < 4; ++kk)
#pragma unroll
                for (int j = 0; j < 4; ++j) { const f32x2 lo = __builtin_amdgcn_cvt_pk_f32_fp8((int)y[kk][j], false), hi2 = __builtin_amdgcn_cvt_pk_f32_fp8((int)y[kk][j], true);
                    v[j][0] += gt[kk] * lo[0]; v[j][1] += gt[kk] * lo[1]; v[j][2] += gt[kk] * hi2[0]; v[j][3] += gt[kk] * hi2[1]; }
#pragma unroll
            for (int j = 0; j < 4; ++j) __builtin_nontemporal_store(v[j], orow + 64 * j);
        }
    } }
}

extern "C" void kernel_launch(void* const* d_in, const int* in_sizes, int n_in, void* d_out, int out_size, void* d_ws, size_t ws_size, hipStream_t stream) {
    static int grid = 0;
    if (grid == 0) {
        if (n_in != 16 || out_size != MTOK * DM || ws_size < WS_END) { fprintf(stderr, "kernel_launch: unexpected shapes (n_in %d, out %d, ws %zu)\n", n_in, out_size, ws_size); grid = -1; return; }
        int dev = 0, cus = 0, per_cu = 0;
        if (hipGetDevice(&dev) != hipSuccess || hipDeviceGetAttribute(&cus, hipDeviceAttributeMultiprocessorCount, dev) != hipSuccess) { grid = -1; return; }
        if (hipFuncSetAttribute((const void*)hymba_fwd, hipFuncAttributeMaxDynamicSharedMemorySize, LDS_BYTES) != hipSuccess) { fprintf(stderr, "kernel_launch: hipFuncSetAttribute failed\n"); grid = -1; return; }
        if (hipOccupancyMaxActiveBlocksPerMultiprocessor(&per_cu, (const void*)hymba_fwd, 512, LDS_BYTES) != hipSuccess || per_cu < 1) { fprintf(stderr, "kernel_launch: occupancy query reports %d blocks per CU\n", per_cu); per_cu = 1; }
        (void)hipGetLastError();
        grid = cus;
        if (grid != 256) fprintf(stderr, "kernel_launch: %d CUs; the attention phase assumes 256 workgroups\n", grid);
    }
    if (grid < 0) return;
    (void)hipMemsetAsync((char*)d_ws + WS_CTL, 0, CTL_ZERO_BYTES, stream);
    Args a{};
    for (int i = 0; i < 16; ++i) a.in[i] = (const float*)d_in[i];
    a.out = (float*)d_out; a.ws = (unsigned char*)d_ws;
    void* params[] = {&a};
    hipError_t e = hipLaunchCooperativeKernel((const void*)hymba_fwd, dim3(grid), dim3(512), params, LDS_BYTES, stream);
    if (e != hipSuccess) fprintf(stderr, "kernel_launch: cooperative launch failed: %s (grid %d)\n", hipGetErrorString(e), grid);
}
```

```cpp
#include <hip/hip_runtime.h>
#include <hip/hip_bf16.h>
#include <cstdio>
#include <cstdint>

#define LAS __attribute__((address_space(3)))
#define GAS __attribute__((address_space(1)))
typedef unsigned short bf16_t;
typedef short bf16x8 __attribute__((ext_vector_type(8)));
typedef short s16x4 __attribute__((ext_vector_type(4)));
typedef float f32x4 __attribute__((ext_vector_type(4)));
typedef float f32x2 __attribute__((ext_vector_type(2)));
typedef float f32x16 __attribute__((ext_vector_type(16)));
typedef unsigned u32x4 __attribute__((ext_vector_type(4)));
typedef unsigned u32x2 __attribute__((ext_vector_type(2)));

constexpr int BATCH = 4, SEQ = 4096, DM = 1024, MTOK = BATCH * SEQ;
constexpr int HD = 64, NPROJ = 2304;
constexpr int COL_QA = 0, COL_KA = 512, COL_VA = 640, COL_QB = 768, COL_KB = 1280, COL_VB = 1792;
constexpr int NE = 32, TOPK = 4, DFF = 1024;
constexpr float NORM_EPS = 1e-5f;
constexpr float LOG2E = 1.4426950408889634f;
constexpr float C2 = 0.125f * LOG2E;
constexpr int LISTCAP = MTOK;

constexpr size_t MiB = 1u << 20;
constexpr size_t WS_CTL = 0, CTL_ZERO_BYTES = 1 * MiB;
constexpr size_t WS_WIN = 2 * MiB;
constexpr size_t WS_WOUT = 8 * MiB;
constexpr size_t WS_WRH = 10 * MiB;
constexpr size_t WS_WRL = 10 * MiB + 65536;
constexpr size_t WS_RT = 11 * MiB;
constexpr size_t WS_TOPE = 11 * MiB + 65536;
constexpr size_t WS_TOPS = WS_TOPE + 262144;
constexpr size_t WS_GATE = WS_TOPS + 262144;
constexpr size_t WS_LIST = 12 * MiB;
constexpr size_t WS_LB = 14 * MiB;
constexpr size_t WS_W1 = 16 * MiB;
constexpr size_t WS_W2 = 144 * MiB;
constexpr size_t WS_XN = 208 * MiB;
constexpr size_t WS_QKV = 240 * MiB;
constexpr size_t WS_OB = 312 * MiB;
constexpr size_t WS_ATT = 360 * MiB;
constexpr size_t WS_HN = 392 * MiB;
constexpr size_t WS_ACT = 424 * MiB;
constexpr size_t WS_Y = 568 * MiB;
constexpr size_t WS_X1 = 712 * MiB;
constexpr size_t WS_END = 776 * MiB;
constexpr int CW_BAR = 4096;
constexpr int CW_CNT = 16384;
constexpr int CW_RTC = 32768;

constexpr int RING_BYTES = 131072;
constexpr int XT_IDX = RING_BYTES;
constexpr int XT_TP = XT_IDX + 24576;
constexpr int XT_CNT = XT_TP + 160;
constexpr int XT_HIST = XT_CNT + 128;
constexpr int XT_BASE = XT_HIST + 128;
constexpr int XT_MISC = XT_BASE + 128;
constexpr int LDS_BYTES = 157696;
static_assert(XT_MISC + 128 <= LDS_BYTES, "LDS map");

#define RLX_AGENT __ATOMIC_RELAXED, __HIP_MEMORY_SCOPE_AGENT
#define LDS_WAIT() asm volatile("s_waitcnt lgkmcnt(0)" ::: "memory")
#define VM_WAIT() asm volatile("s_waitcnt vmcnt(0)" ::: "memory")

__device__ __forceinline__ unsigned f2bf(float f) { unsigned u = __builtin_bit_cast(unsigned, f); return (u + 0x7fffu + ((u >> 16) & 1u)) >> 16; }
__device__ __forceinline__ unsigned pk2(float lo, float hi) { unsigned r; asm volatile("v_cvt_pk_bf16_f32 %0, %1, %2" : "=v"(r) : "v"(lo), "v"(hi)); return r; }
__device__ __forceinline__ float bf2f(unsigned h) { return __builtin_bit_cast(float, h << 16); }
__device__ __forceinline__ unsigned cvt_pk_bf16(float lo, float hi) { unsigned r; asm volatile("v_cvt_pk_bf16_f32 %0, %1, %2" : "=v"(r) : "v"(lo), "v"(hi)); return r; }
__device__ __forceinline__ float wave_sum(float v) {
#pragma unroll
    for (int o = 1; o < 64; o <<= 1) v += __shfl_xor(v, o);
    return v;
}
__device__ __forceinline__ float wave_max(float v) {
#pragma unroll
    for (int o = 1; o < 64; o <<= 1) v = fmaxf(v, __shfl_xor(v, o));
    return v;
}

namespace pg8 {
constexpr int BM = 256, BK = 64, HALF = 128, HTB = HALF * BK * 2, KDIM = 1024;
__host__ __device__ __forceinline__ int lds_byte(int r, int c) { const int st = (r >> 4) * 2 + (c >> 5), rr = r & 15, cc = c & 31, ob = rr * 64 + cc * 2; return st * 1024 + (ob ^ (((ob >> 9) & 1) << 5)); }
__host__ __device__ __forceinline__ void stage_rc(int b, int& R, int& C) { const int st = b / 1024, sb = b % 1024, swz = sb ^ (((sb >> 9) & 1) << 5); R = (st >> 1) * 16 + swz / 64; C = (st & 1) * 32 + (swz % 64) / 2; }
__host__ __device__ __forceinline__ int perm32(int rho) { const int n = rho >> 4, i = rho & 15; return 8 * (i >> 2) + 4 * n + (i & 3); }

struct UnitD { const char* A; const char* B; int pm, pn, e, ui, kind; unsigned bh; };

typedef int v8i __attribute__((ext_vector_type(8)));
typedef int v4i __attribute__((ext_vector_type(4)));
__device__ __forceinline__ void glds4_sc1(const void* gsrc, unsigned lds_dst) { unsigned keep;
    asm volatile("s_mov_b32 %0, m0\n\ts_mov_b32 m0, %2\n\ts_nop 0\n\tglobal_load_lds_dword %1, off sc1\n\ts_mov_b32 m0, %0" : "=&s"(keep) : "v"(gsrc), "s"(lds_dst) : "memory"); }
template <class Epi, class Sched, int BMODE, bool GATHER, bool FP8, bool FLOW = false>
__device__ __forceinline__ void gemm_phase(LAS unsigned char* lds, const Sched& S, const Epi& E, const unsigned bhstep) {
    constexpr int ROWB = FP8 ? 1024 : 2048, nt = FP8 ? 8 : 16;
    const int tid = threadIdx.x, wid = __builtin_amdgcn_readfirstlane(tid >> 6), lane = tid & 63, wr = wid >> 2, wc = wid & 3, fr = lane & 15, fq = lane >> 4;
    unsigned voffA[GATHER ? 2 : 1][2], voffB[2];
#pragma unroll
    for (int i = 0; i < 2; ++i) { int R, C; stage_rc(tid * 16 + i * 8192, R, C);
        const int Rb = BMODE == 0 ? R : (BMODE == 1 ? ((R & ~31) + perm32(R & 31)) : (2 * (R & ~31) + perm32(R & 31)));
        voffB[i] = (unsigned)(Rb * ROWB + C * 2);
        voffA[0][i] = (unsigned)(R * ROWB + C * 2); if constexpr (GATHER) voffA[1][i] = 0u; }
    int sclX = 0x7F7F7F7F; asm volatile("" : "+v"(sclX));
    const size_t kstep = (size_t)(BK * 2);
    const unsigned ldsw = (unsigned)wid * 1024u;
    const int aoff = lds_byte(wr * 64 + fr, fq * 8), boff = lds_byte(wc * 32 + fr, fq * 8);
    LAS unsigned char* Ap = lds + aoff; LAS unsigned char* Bp = lds + boff + 4 * HTB;
    asm volatile("" : "+v"(Ap)); asm volatile("" : "+v"(Bp));
#define PG8_SA(b, h) (((b) * 2 + (h)) * HTB)
#define PG8_SB(b, h) ((4 + (b) * 2 + (h)) * HTB)
#define PG8_STAGE_X(bufoff, gbase, voff, AUX) do { _Pragma("unroll") for (int _i = 0; _i < 2; ++_i) \
        __builtin_amdgcn_global_load_lds((const unsigned*)((const char*)(gbase) + (voff)[_i]), (LAS unsigned*)(lds + (bufoff) + ldsw + _i * 8192), 16, 0, AUX); } while (0)
#define PG8_STAGE(bufoff, gbase, voff) PG8_STAGE_X(bufoff, gbase, voff, 0)
#define PG8_STAGE_A(b, h, gbase) do { if constexpr (GATHER) { PG8_STAGE(PG8_SA(b, h), gbase, voffA[h]); } else { PG8_STAGE(PG8_SA(b, h), (gbase) + (h) * (HALF * ROWB), voffA[0]); } } while (0)
#define PG8_RDA(off) (*(const LAS v4i*)(Ap + (off)))
#define PG8_RDB(off) (*(const LAS v4i*)(Bp + (off)))
#define PG8_LDA(dst, b, h) do { _Pragma("unroll") for (int m = 0; m < 4; ++m) { if constexpr (FP8) dst##8[m] = __builtin_shufflevector(PG8_RDA(PG8_SA(b, h) + m * 2048), PG8_RDA(PG8_SA(b, h) + m * 2048 + 1024), 0, 1, 2, 3, 4, 5, 6, 7); \
        else { _Pragma("unroll") for (int k = 0; k < 2; ++k) dst[m][k] = __builtin_bit_cast(bf16x8, PG8_RDA(PG8_SA(b, h) + m * 2048 + k * 1024)); } } } while (0)
#define PG8_LDB(dst, b, h) do { _Pragma("unroll") for (int n = 0; n < 2; ++n) { if constexpr (FP8) dst##8[n] = __builtin_shufflevector(PG8_RDB(PG8_SA(b, h) + n * 2048), PG8_RDB(PG8_SA(b, h) + n * 2048 + 1024), 0, 1, 2, 3, 4, 5, 6, 7); \
        else { _Pragma("unroll") for (int k = 0; k < 2; ++k) dst[n][k] = __builtin_bit_cast(bf16x8, PG8_RDB(PG8_SA(b, h) + n * 2048 + k * 1024)); } } } while (0)
#define PG8_MMA(ai, bj, At, Bt) do { __builtin_amdgcn_s_setprio(1); _Pragma("unroll") for (int m = 0; m < 4; ++m) _Pragma("unroll") for (int n = 0; n < 2; ++n) { \
        if constexpr (FP8) { acc[ai][bj][m][n] = __builtin_amdgcn_mfma_scale_f32_16x16x128_f8f6f4(Bt##8[n], At##8[m], acc[ai][bj][m][n], 0, 0, 0, sclX, 0, sclX); } \
        else { _Pragma("unroll") for (int k = 0; k < 2; ++k) acc[ai][bj][m][n] = __builtin_amdgcn_mfma_f32_16x16x32_bf16(Bt[n][k], At[m][k], acc[ai][bj][m][n], 0, 0, 0); } } \
        __builtin_amdgcn_s_setprio(0); } while (0)
#define PG8_WAIT_V(n) asm volatile("s_waitcnt vmcnt(" #n ")" ::: "memory")
#define PG8_WAIT_L(n) asm volatile("s_waitcnt lgkmcnt(" #n ")" ::: "memory")
#define PG8_BAR __builtin_amdgcn_s_barrier()
#define PG8_SCHED __builtin_amdgcn_sched_barrier(0)
#define PG8_GIDX(uord, U) do { if constexpr (GATHER) { const LAS int* _ix = S.idx(uord); _Pragma("unroll") for (int _i = 0; _i < 2; ++_i) { int R, C; stage_rc(tid * 16 + _i * 8192, R, C); \
        voffA[0][_i] = (unsigned)(_ix[R] * ROWB + C * 2); voffA[1][_i] = (unsigned)(_ix[R + HALF] * ROWB + C * 2); } } } while (0)
#define PG8_DEPSPIN(rt, c0) do { unsigned _c = (c0), _sp = 0; const unsigned* _p = S.cnt + (rt) * 16; \
        while (_c < 64u && ++_sp < (1u << 18)) { __builtin_amdgcn_s_sleep(2); unsigned _t; asm volatile("global_load_dword %0, %1, %2 sc1\n\ts_waitcnt vmcnt(0)" : "=v"(_t) : "v"(0), "s"(_p) : "memory"); _c = (unsigned)__builtin_amdgcn_readfirstlane(_t); } } while (0)
    UnitD cur, nxt; int ui = 0;
    if (!S.next(0, cur)) return;
    f32x4 acc[2][2][4][2];
#pragma unroll
    for (int a = 0; a < 2; ++a)
#pragma unroll
        for (int b = 0; b < 2; ++b)
#pragma unroll
            for (int m = 0; m < 4; ++m)
#pragma unroll
                for (int n = 0; n < 2; ++n) acc[a][b][m][n] = (f32x4){0.f, 0.f, 0.f, 0.f};
    bf16x8 At[FP8 ? 1 : 4][2], B0[2][2], B1[2][2]; v8i At8[4], B08[2], B18[2];
    const char* cA = cur.A; const char* cB = cur.B; unsigned cbh = bhstep; if constexpr (FLOW) cbh = cur.bh;
    const unsigned dslot = (unsigned)(size_t)(lds + XT_MISC + 96) + (unsigned)wid * 4u; int rtp = 0;
    if constexpr (FLOW) {
#pragma unroll
        for (int k = 0; k < 3; ++k) { int rt_; if (S.dep(k, rt_)) PG8_DEPSPIN(rt_, 0u); }
        if (lane == 0) asm volatile("ds_write_b32 %0, %1" :: "v"(dslot), "v"(64u) : "memory");
    }
    PG8_GIDX(0, cur);
    PG8_STAGE(PG8_SB(0, 0), cB, voffB); PG8_STAGE(PG8_SB(0, 1), cB + cbh, voffB); PG8_STAGE_A(0, 0, cA); PG8_STAGE_A(0, 1, cA);
    if (wr == 1) PG8_BAR;
    PG8_WAIT_V(2); PG8_BAR;
    PG8_STAGE(PG8_SB(1, 0), cB + kstep, voffB); PG8_STAGE_A(1, 0, cA + kstep); PG8_STAGE(PG8_SB(1, 1), cB + cbh + kstep, voffB);
    PG8_WAIT_V(6); PG8_BAR;
    for (;;) {
        const bool has_next = S.next(ui + 1, nxt);
        const char* nA = has_next ? nxt.A : cA; const char* nB = has_next ? nxt.B : cB; unsigned nbh = cbh; if constexpr (FLOW) nbh = has_next ? nxt.bh : cbh;
#pragma clang loop unroll(disable)
        for (int t = 0; t < nt; t += 2) {
            const bool last = (t == nt - 2);
            const char* a1 = cA + (size_t)(t + 1) * kstep;
            const char* a2 = last ? nA : cA + (size_t)(t + 2) * kstep; const char* b2 = last ? nB : cB + (size_t)(t + 2) * kstep;
            const char* a3 = a2 + kstep; const char* b3 = b2 + kstep; const unsigned bh2 = (FLOW && last) ? nbh : cbh;
            PG8_LDB(B0, 0, 0); PG8_LDB(B1, 0, 1); PG8_SCHED; PG8_LDA(At, 0, 0); PG8_STAGE_A(1, 1, a1);
            if (GATHER && last && has_next) { PG8_GIDX(ui + 1, nxt); }
            PG8_WAIT_V(8); PG8_WAIT_L(0); PG8_BAR; PG8_MMA(0, 0, At, B0); PG8_MMA(0, 1, At, B1); PG8_BAR; PG8_SCHED;
            PG8_LDA(At, 0, 1); PG8_STAGE(PG8_SB(0, 0), b2, voffB); PG8_STAGE(PG8_SB(0, 1), b2 + bh2, voffB); PG8_STAGE_A(0, 0, a2);
            PG8_WAIT_V(8); PG8_WAIT_L(0); PG8_BAR; PG8_MMA(1, 0, At, B0); PG8_MMA(1, 1, At, B1); PG8_BAR; PG8_SCHED;
            PG8_LDB(B0, 1, 0); PG8_LDB(B1, 1, 1); PG8_SCHED; PG8_LDA(At, 1, 0); PG8_STAGE_A(0, 1, a2);
            PG8_WAIT_V(8); PG8_WAIT_L(0); PG8_BAR; PG8_MMA(0, 0, At, B0); PG8_MMA(0, 1, At, B1); PG8_BAR; PG8_SCHED;
            PG8_LDA(At, 1, 1); PG8_STAGE(PG8_SB(1, 0), b3, voffB); PG8_STAGE(PG8_SB(1, 1), b3 + bh2, voffB); PG8_STAGE_A(1, 0, a3);
            PG8_WAIT_V(8); PG8_WAIT_L(0); PG8_BAR; PG8_MMA(1, 0, At, B0); PG8_MMA(1, 1, At, B1); PG8_BAR; PG8_SCHED;
        }
        if (wr == 0) PG8_BAR;
        unsigned cdep = 64u; int rt3 = 0;
        if constexpr (FLOW) { unsigned cv; asm volatile("ds_read_b32 %0, %1\n\ts_waitcnt lgkmcnt(0)" : "=v"(cv) : "v"(dslot) : "memory"); cdep = (unsigned)__builtin_amdgcn_readfirstlane(cv);
            const bool d3 = S.dep(ui + 3, rt3);
            if (lane == 0) { if (d3) glds4_sc1(S.cnt + rt3 * 16, dslot); else asm volatile("ds_write_b32 %0, %1" :: "v"(dslot), "v"(64u) : "memory"); } }
        { int l2; asm volatile("v_mbcnt_lo_u32_b32 %0, -1, 0\n\tv_mbcnt_hi_u32_b32 %0, -1, %0" : "=v"(l2)); E(acc, cur, wr, wc, l2 & 15, l2 >> 4); }
        if constexpr (FLOW) {
            if (cur.kind == 0) { if (lane == 0) (void)__hip_atomic_fetch_add(S.cnt + cur.pm * 16, 1u, RLX_AGENT); }
            PG8_DEPSPIN(rtp, cdep); rtp = rt3; }
        if (!has_next) break;
#pragma unroll
        for (int a = 0; a < 2; ++a)
#pragma unroll
            for (int b = 0; b < 2; ++b)
#pragma unroll
                for (int m = 0; m < 4; ++m)
#pragma unroll
                    for (int n = 0; n < 2; ++n) acc[a][b][m][n] = (f32x4){0.f, 0.f, 0.f, 0.f};
        cur = nxt; cA = nA; cB = nB; cbh = nbh; ++ui;
        if (wr == 1) PG8_BAR;
    }
    PG8_WAIT_V(0);
    PG8_BAR;
#undef PG8_SA
#undef PG8_SB
#undef PG8_STAGE
#undef PG8_LDA
#undef PG8_LDB
#undef PG8_MMA
#undef PG8_RDA
#undef PG8_STAGE_A
#undef PG8_RDB
#undef PG8_WAIT_V
#undef PG8_WAIT_L
#undef PG8_BAR
#undef PG8_SCHED
#undef PG8_GIDX
#undef PG8_DEPSPIN
#undef PG8_STAGE_X
}

struct StaticOrder {
    int nM, nN, nwg, G, c; const char* A; const char* B; const LAS int* ix;
    __device__ void init(int M, int N, int G_, int c_, const void* A_, const void* B_) { nM = M / BM; nN = N / BM; nwg = nM * nN; G = G_; c = c_; A = (const char*)A_; B = (const char*)B_; ix = nullptr; }
    __device__ __forceinline__ bool next(int i, UnitD& u) const {
        const long L = (long)i * G + c; if (L >= nwg) return false;
        int wgid = (int)L; { const int q = nwg / 8, r = nwg % 8, xcd = wgid % 8, off = wgid / 8; wgid = (xcd < r ? xcd * (q + 1) : r * (q + 1) + (xcd - r) * q) + off; }
        const int WGM = 4, nig = WGM * nN, gid = wgid / nig, fm = gid * WGM, gsz = (nM - fm) < WGM ? (nM - fm) : WGM;
        u.pm = fm + ((wgid % nig) % gsz); u.pn = (wgid % nig) / gsz; u.e = 0; u.ui = i;
        u.A = A + (size_t)u.pm * (BM * KDIM * 2); u.B = B + (size_t)u.pn * (BM * KDIM * 2); return true;
    }
    __device__ __forceinline__ const LAS int* idx(int) const { return ix; }
};

__device__ __forceinline__ bool moe_unit(int i, int vcu, int NT, int ncol, int& rt, int& pn) {
    const int x = vcu >> 5, u = i * 32 + (vcu & 31), r0 = (x * NT) >> 3, r1 = ((x + 1) * NT) >> 3, rl = u / ncol;
    if (rl >= r1 - r0) return false;
    rt = r0 + rl; pn = u - rl * ncol; return true;
}
struct MoeOrder {
    int G, vcu, ncol, NT; const LAS int* tp; const LAS int* ixt; const char* A; const char* B; size_t bexp, bcol, astride; bool gather;
    __device__ __forceinline__ bool next(int i, UnitD& u) const {
        int rt, pn; if (!moe_unit(i, vcu, NT, ncol, rt, pn)) return false;
        int e = 0;
        for (int j = 1; j < NE; ++j) e += (rt >= tp[j]) ? 1 : 0;
        e = __builtin_amdgcn_readfirstlane(e);
        u.pm = rt; u.pn = pn; u.e = e; u.ui = i;
        u.A = gather ? A : A + (size_t)rt * astride;
        u.B = B + (size_t)e * bexp + (size_t)pn * bcol; return true;
    }
    __device__ __forceinline__ const LAS int* idx(int uord) const { return ixt + uord * 256; }
};

struct MoeFlow {
    int q, n, r0, nr; const LAS int* tp; const LAS int* ixt; const char* ws; unsigned* cnt;
    __device__ __forceinline__ bool next(int i, UnitD& u) const {
        const int L = i * n + q, n5 = nr * 8; int kind, rl, pn;
        if (L < n5) { kind = 0; rl = L >> 3; pn = L & 7; } else { const int L2 = L - n5; if (L2 >= nr * 4) return false; kind = 1; rl = L2 >> 2; pn = L2 & 3; }
        const int rt = r0 + rl; int e = 0;
        for (int j = 1; j < NE; ++j) e += (rt >= tp[j]) ? 1 : 0;
        e = __builtin_amdgcn_readfirstlane(e);
        u.pm = rt; u.pn = pn; u.e = e; u.ui = i; u.kind = kind;
        u.A = ws + (kind ? WS_ACT : WS_HN); u.bh = kind ? 128u * 1024u : 1024u * 1024u;
        u.B = ws + (kind ? WS_W2 + (size_t)e * (1024 * 1024) + (size_t)pn * (256 * 1024) : WS_W1 + (size_t)e * (2048 * 1024) + (size_t)pn * (128 * 1024)); return true;
    }
    __device__ __forceinline__ const LAS int* idx(int uord) const { return ixt + uord * 256; }
    __device__ __forceinline__ bool dep(int i, int& rt) const { const int L2 = i * n + q - nr * 8; rt = r0 + (L2 >> 2); return L2 >= 0 && L2 < nr * 4; }
};

struct EpiQKV {
    bf16_t* O; const float *gqa, *gka, *gqb, *gkb;
    __device__ __forceinline__ void operator()(const f32x4 (&acc)[2][2][4][2], const UnitD& u, int wr, int wc, int fr, int fq) const {
        const int head = 4 * u.pn + wc; const float* g = nullptr; float sc = 1.f;
        if (head < 8) { g = gqa; sc = C2; } else if (head < 10) { g = gka; } else if (head < 12) { g = nullptr; } else if (head < 20) { g = gqb; sc = C2; } else if (head < 28) { g = gkb; }
        f32x4 gv[2][2];
#pragma unroll
        for (int bj = 0; bj < 2; ++bj)
#pragma unroll
            for (int n = 0; n < 2; ++n) gv[bj][n] = g ? *(const f32x4*)(g + 32 * bj + 8 * fq + 4 * n) * sc : (f32x4){1.f, 1.f, 1.f, 1.f};
        const int row0 = u.pm * BM + wr * 64 + fr, col0 = u.pn * BM + wc * 64 + 8 * fq;
#pragma unroll
        for (int ai = 0; ai < 2; ++ai)
#pragma unroll
            for (int m = 0; m < 4; ++m) {
                float rs = 1.f;
                if (g) { float ss = 0.f;
#pragma unroll
                    for (int bj = 0; bj < 2; ++bj)
#pragma unroll
                        for (int n = 0; n < 2; ++n) { const f32x4 v = acc[ai][bj][m][n]; ss += (v[0] * v[0] + v[1] * v[1]) + (v[2] * v[2] + v[3] * v[3]); }
                    ss += __shfl_xor(ss, 16); ss += __shfl_xor(ss, 32);
                    rs = __builtin_amdgcn_rsqf(ss * (1.f / 64.f) + NORM_EPS); }
                bf16_t* rowp = O + (size_t)(row0 + ai * HALF + m * 16) * NPROJ + col0;
#pragma unroll
                for (int bj = 0; bj < 2; ++bj) { const f32x4 v0 = acc[ai][bj][m][0] * rs * gv[bj][0], v1 = acc[ai][bj][m][1] * rs * gv[bj][1];
                    u32x4 w; w.x = cvt_pk_bf16(v0[0], v0[1]); w.y = cvt_pk_bf16(v0[2], v0[3]); w.z = cvt_pk_bf16(v1[0], v1[1]); w.w = cvt_pk_bf16(v1[2], v1[3]);
                    *(u32x4*)(rowp + bj * 32) = w; }
            }
    }
};
struct EpiX1 {
    const float* base; float* out;
    __device__ __forceinline__ void operator()(const f32x4 (&acc)[2][2][4][2], const UnitD& u, int wr, int wc, int fr, int fq) const {
        const int col0 = u.pn * BM + wc * 32 + 4 * fq;
#pragma unroll
        for (int ai = 0; ai < 2; ++ai)
#pragma unroll
            for (int m = 0; m < 4; ++m) { const size_t off = (size_t)(u.pm * BM + ai * HALF + wr * 64 + m * 16 + fr) * DM + col0;
#pragma unroll
                for (int bj = 0; bj < 2; ++bj)
#pragma unroll
                    for (int n = 0; n < 2; ++n) { const f32x4 bs = __builtin_nontemporal_load((const f32x4*)(base + off + bj * HALF + n * 16)); *(f32x4*)(out + off + bj * HALF + n * 16) = bs + acc[ai][bj][m][n]; } }
    }
};
struct EpiAct {
    unsigned char* ACT; const float* b1;
    __device__ __forceinline__ void operator()(const f32x4 (&acc)[2][2][4][2], const UnitD& u, int wr, int wc, int fr, int fq) const {
        const int col0 = u.pn * 128 + wc * 32 + 8 * fq; const float* bg = b1 + (size_t)u.e * 2048 + col0;
        f32x4 bgl[2], bln[2];
#pragma unroll
        for (int n = 0; n < 2; ++n) { bgl[n] = *(const f32x4*)(bg + 4 * n); bln[n] = *(const f32x4*)(bg + 1024 + 4 * n) + 1.0f; }
#pragma unroll
        for (int ai = 0; ai < 2; ++ai)
#pragma unroll
            for (int m = 0; m < 4; ++m) { const int rl = ai * HALF + wr * 64 + m * 16 + fr; const float rs = 1.0f / 64.0f;
                unsigned w[2];
#pragma unroll
                for (int n = 0; n < 2; ++n) { const f32x4 gl = acc[ai][0][m][n] * rs + bgl[n], ln = acc[ai][1][m][n] * rs + bln[n]; float a[4];
#pragma unroll
                    for (int e = 0; e < 4; e += 2) {
                        const f32x2 gg = (f32x2){fminf(gl[e], 7.0f), fminf(gl[e + 1], 7.0f)}, ll = (f32x2){__builtin_amdgcn_fmed3f(ln[e], -6.0f, 8.0f), __builtin_amdgcn_fmed3f(ln[e + 1], -6.0f, 8.0f)};
                        const f32x2 t = gg * (-1.702f * LOG2E); f32x2 den = (f32x2){__builtin_amdgcn_exp2f(t[0]), __builtin_amdgcn_exp2f(t[1])} + 1.0f;
                        const f32x2 rr = (f32x2){__builtin_amdgcn_rcpf(den[0]), __builtin_amdgcn_rcpf(den[1])}; const f32x2 av = (gg * ll) * rr; a[e] = av[0]; a[e + 1] = av[1]; }
                    int p = 0; p = __builtin_amdgcn_cvt_pk_fp8_f32(a[0], a[1], p, false); p = __builtin_amdgcn_cvt_pk_fp8_f32(a[2], a[3], p, true); w[n] = (unsigned)p; }
                *(u32x2*)(ACT + (size_t)(u.pm * BM + rl) * DFF + col0) = (u32x2){w[0], w[1]}; }
    }
};
struct EpiY {
    unsigned char* Y; const float* b2;
    __device__ __forceinline__ void operator()(const f32x4 (&acc)[2][2][4][2], const UnitD& u, int wr, int wc, int fr, int fq) const {
        const int col0 = u.pn * BM + wc * 32 + 8 * fq; const float* bb = b2 + (size_t)u.e * DM + col0;
        f32x4 bv[2][2];
#pragma unroll
        for (int bj = 0; bj < 2; ++bj)
#pragma unroll
            for (int n = 0; n < 2; ++n) bv[bj][n] = *(const f32x4*)(bb + bj * HALF + 4 * n);
#pragma unroll
        for (int ai = 0; ai < 2; ++ai)
#pragma unroll
            for (int m = 0; m < 4; ++m) { unsigned char* rowp = Y + (size_t)(u.pm * BM + ai * HALF + wr * 64 + m * 16 + fr) * DM + col0;
#pragma unroll
                for (int bj = 0; bj < 2; ++bj) { const f32x4 v0 = acc[ai][bj][m][0] * (1.0f / 64.0f) + bv[bj][0], v1 = acc[ai][bj][m][1] * (1.0f / 64.0f) + bv[bj][1];
                    int p0 = 0, p1 = 0; p0 = __builtin_amdgcn_cvt_pk_fp8_f32(v0[0], v0[1], p0, false); p0 = __builtin_amdgcn_cvt_pk_fp8_f32(v0[2], v0[3], p0, true);
                    p1 = __builtin_amdgcn_cvt_pk_fp8_f32(v1[0], v1[1], p1, false); p1 = __builtin_amdgcn_cvt_pk_fp8_f32(v1[2], v1[3], p1, true);
                    *(u32x2*)(rowp + bj * HALF) = (u32x2){(unsigned)p0, (unsigned)p1}; } }
    }
};
struct EpiMoe {
    EpiAct a; EpiY y; unsigned* cnt;
    __device__ __forceinline__ void operator()(const f32x4 (&acc)[2][2][4][2], const UnitD& u, int wr, int wc, int fr, int fq) const {
        if (u.kind == 0) { a(acc, u, wr, wc, fr, fq); asm volatile("s_waitcnt vmcnt(0)" ::: "memory"); }
        else y(acc, u, wr, wc, fr, fq);
    }
};
}

namespace att {
typedef LAS const char* lds_cptr;
typedef short v4i16_t __attribute__((ext_vector_type(4)));
__device__ __forceinline__ int crow(int r, int hi) { return (r & 3) + 8 * (r >> 2) + 4 * hi; }
__device__ __forceinline__ void glds16(const void* gsrc, unsigned lds_dst) { unsigned keep;
    asm volatile("s_mov_b32 %0, m0\n\ts_mov_b32 m0, %2\n\ts_nop 0\n\tglobal_load_lds_dwordx4 %1, off\n\ts_mov_b32 m0, %0" : "=&s"(keep) : "v"(gsrc), "s"(lds_dst) : "memory"); }
__device__ __forceinline__ s16x4 vtr(lds_cptr p) { return __builtin_bit_cast(s16x4, __builtin_amdgcn_ds_read_tr16_b64_v4i16((LAS v4i16_t*)p)); }

struct WU {
    const bf16_t* P;
    int seq0;
    int dil, L, hw;
    int J0u, NTU;
    int U0, toff;
    int qcol, kcol, vcol;
    float slope2, negc, sinkp;
    bf16_t* O; int opitch, ocol;
    float* lout; int lstride, lcol;
};

__device__ __forceinline__ void issue_tile(const WU& w, char* base, int t, int lane) {
    const unsigned lds0 = (unsigned)(uintptr_t)base;
    const unsigned kd = (unsigned)__builtin_amdgcn_readfirstlane(lds0 + t * 8192);
#pragma unroll
    for (int i = 0; i < 4; ++i) { const int kl = 8 * i + (lane >> 3); int jk = w.J0u + 32 * t + kl; jk = jk < 0 ? 0 : (jk > w.L - 1 ? w.L - 1 : jk);
        glds16(w.P + (size_t)(w.seq0 + jk * w.dil) * NPROJ + w.kcol + (((lane & 7) ^ ((kl >> 1) & 7)) << 3), kd + i * 1024); }
#pragma unroll
    for (int i = 0; i < 4; ++i) { const int kl = 8 * i + (lane >> 3); int jv = w.J0u + 32 * t + kl; jv = jv < 0 ? 0 : (jv > w.L - 1 ? w.L - 1 : jv);
        glds16(w.P + (size_t)(w.seq0 + jv * w.dil) * NPROJ + w.vcol + (((lane & 7) ^ (((kl >> 1) & 1) << 2)) << 3), kd + 4096 + i * 1024); }
}
__device__ __forceinline__ void load_unit(const WU& w, char* base, int wave, int lane) {
    for (int t = wave; t < w.NTU; t += 8) { const int jf = w.J0u + 32 * t; if (jf + 31 < 0 || jf >= w.L) continue; issue_tile(w, base, t, lane); }
}
__device__ __forceinline__ void compute_unit(const WU& w, char* base, f32x16 (&o)[2], float& lsum_out) {
    const int lane = threadIdx.x & 63, r32 = lane & 31, hi = lane >> 5;
    const lds_cptr b3 = (lds_cptr)base;
    const int HW = w.hw, NT = (32 + 2 * HW) / 32;
    const int J0 = w.U0 - HW;
    const int klo = (-J0 / 32) > 0 ? (-J0 / 32) : 0;
    const int khi = ((w.L - J0) / 32 - 1) < (NT - 1) ? ((w.L - J0) / 32 - 1) : (NT - 1);
    const bool edge = (J0 < 0) || (w.U0 + 32 + HW > w.L);
    const int qtok = w.seq0 + (w.U0 + r32) * w.dil;
    bf16x8 qr[4];
#pragma unroll
    for (int c = 0; c < 4; ++c) qr[c] = *(const bf16x8*)(w.P + (size_t)qtok * NPROJ + w.qcol + c * 16 + hi * 8);
    f32x16 negcv;
#pragma unroll
    for (int r = 0; r < 16; ++r) negcv[r] = w.negc;
    o[0] = f32x16{}; o[1] = f32x16{};
    float lsum = 0.f;
    const float lof = fmaxf((float)-HW, (float)-(w.U0 + r32)), hif = fminf((float)HW, (float)(w.L - 1 - w.U0 - r32));
    for (int k = klo; k <= khi; ++k) {
        const int sl = w.toff + k;
        const lds_cptr kp = b3 + sl * 8192 + r32 * 128;
        bf16x8 kf[4];
#pragma unroll
        for (int c = 0; c < 4; ++c) kf[c] = *(const LAS bf16x8*)(kp + (((2 * c + hi) ^ ((r32 >> 1) & 7)) << 4));
        f32x16 s = __builtin_amdgcn_mfma_f32_32x32x16_bf16(kf[0], qr[0], negcv, 0, 0, 0);
        s = __builtin_amdgcn_mfma_f32_32x32x16_bf16(kf[1], qr[1], s, 0, 0, 0);
        s = __builtin_amdgcn_mfma_f32_32x32x16_bf16(kf[2], qr[2], s, 0, 0, 0);
        s = __builtin_amdgcn_mfma_f32_32x32x16_bf16(kf[3], qr[3], s, 0, 0, 0);
        const float cf = (float)(32 * k - HW + 4 * hi - r32);
        const bool masked = edge || (k == 0) || (k == NT - 1);
        const int R0 = 32 * k - HW;
        if (masked) {
#pragma unroll
            for (int r = 0; r < 16; ++r) { const float rel = cf + (float)((r & 3) + 8 * (r >> 2)); const float x = __builtin_fmaf(-w.slope2, __builtin_fabsf(rel), s[r]);
                const float p = __builtin_amdgcn_exp2f(x); s[r] = (rel >= lof && rel <= hif) ? p : 0.f; }
        } else if (R0 != 0) {
            const float sg = R0 < 0 ? w.slope2 : -w.slope2; const f32x2 cf2 = (f32x2){cf, cf}, sg2 = (f32x2){sg, sg};
#pragma unroll
            for (int r = 0; r < 16; r += 2) { const f32x2 c2 = (f32x2){(float)((r & 3) + 8 * (r >> 2)), (float)(((r + 1) & 3) + 8 * ((r + 1) >> 2))};
                const f32x2 x2 = __builtin_elementwise_fma(sg2, cf2 + c2, (f32x2){s[r], s[r + 1]});
                s[r] = __builtin_amdgcn_exp2f(x2[0]); s[r + 1] = __builtin_amdgcn_exp2f(x2[1]); }
        } else {
#pragma unroll
            for (int r = 0; r < 16; ++r) { const float rel = cf + (float)((r & 3) + 8 * (r >> 2)); const float x = __builtin_fmaf(-w.slope2, __builtin_fabsf(rel), s[r]);
                s[r] = __builtin_amdgcn_exp2f(x); }
        }
        { f32x2 a2 = (f32x2){s[0], s[1]} + (f32x2){s[2], s[3]}, b2 = (f32x2){s[4], s[5]} + (f32x2){s[6], s[7]}, c2 = (f32x2){s[8], s[9]} + (f32x2){s[10], s[11]}, d2 = (f32x2){s[12], s[13]} + (f32x2){s[14], s[15]};
          a2 = (a2 + b2) + (c2 + d2); lsum += a2[0] + a2[1]; }
        u32x4 pw0, pw1;
        pw0.x = cvt_pk_bf16(s[0], s[1]); pw0.y = cvt_pk_bf16(s[2], s[3]); pw0.z = cvt_pk_bf16(s[4], s[5]); pw0.w = cvt_pk_bf16(s[6], s[7]);
        pw1.x = cvt_pk_bf16(s[8], s[9]); pw1.y = cvt_pk_bf16(s[10], s[11]); pw1.z = cvt_pk_bf16(s[12], s[13]); pw1.w = cvt_pk_bf16(s[14], s[15]);
        const int vq = (lane & 15) >> 2, vg = (lane >> 4) & 1, vpp = lane & 3, vqb = (vq >> 1) & 1;
        const lds_cptr vbase = b3 + sl * 8192 + 4096 + (4 * hi + vq) * 128 + (2 * vg + (vpp >> 1)) * 16 + (vpp & 1) * 8;
#pragma unroll
        for (int d0 = 0; d0 < 2; ++d0) {
            const lds_cptr vp = vbase + ((d0 ^ vqb) << 6);
            const s16x4 l0 = vtr(vp), h0 = vtr(vp + 1024), l1 = vtr(vp + 2048), h1 = vtr(vp + 3072);
            const bf16x8 vf0 = (bf16x8){l0[0], l0[1], l0[2], l0[3], h0[0], h0[1], h0[2], h0[3]}, vf1 = (bf16x8){l1[0], l1[1], l1[2], l1[3], h1[0], h1[1], h1[2], h1[3]};
            o[d0] = __builtin_amdgcn_mfma_f32_32x32x16_bf16(__builtin_bit_cast(bf16x8, pw0), vf0, o[d0], 0, 0, 0);
            o[d0] = __builtin_amdgcn_mfma_f32_32x32x16_bf16(__builtin_bit_cast(bf16x8, pw1), vf1, o[d0], 0, 0, 0);
        }
    }
    lsum += __shfl_xor(lsum, 32);
    lsum += w.sinkp;
    lsum_out = lsum;
}
__device__ __forceinline__ void store_unit(const WU& w, const f32x16 (&o)[2], float lsum, LAS bf16_t* stg, LAS float* wsf) {
    const int lane = threadIdx.x & 63, r32 = lane & 31, hi = lane >> 5;
    if (hi == 0) wsf[r32] = lsum;
    LDS_WAIT();
    float rli[16];
#pragma unroll
    for (int r = 0; r < 16; ++r) rli[r] = __builtin_amdgcn_rcpf(wsf[crow(r, hi)]);
#pragma unroll
    for (int r = 0; r < 16; ++r) { const int orow = crow(r, hi); const unsigned pk = cvt_pk_bf16(o[0][r] * rli[r], o[1][r] * rli[r]);
        stg[orow * 64 + r32] = (bf16_t)(pk & 0xffffu); stg[orow * 64 + 32 + r32] = (bf16_t)(pk >> 16); }
    LDS_WAIT();
#pragma unroll
    for (int i = 0; i < 4; ++i) { const int row = i * 8 + (lane >> 3), ch = lane & 7; const u32x4 v = *(const LAS u32x4*)(stg + row * 64 + ch * 8);
        const int tok = w.seq0 + (w.U0 + row) * w.dil; *(u32x4*)(w.O + (size_t)tok * w.opitch + w.ocol + ch * 8) = v; }
    if (w.lout && hi == 0) { const int qtok = w.seq0 + (w.U0 + r32) * w.dil; w.lout[(size_t)qtok * w.lstride + w.lcol] = lsum; }
    LDS_WAIT();
}
}

#define XB_TMO      128
#define XB_XCNT(j)  (256  + 64 * (j))
#define XB_XSUB(j)  (1280 + 64 * (j))
#define XB_XGEN(j)  (2304 + 64 * (j))
#define XB_TOP      3328
#define XB_TOPGEN   3392
#define XB_SPIN_CAP (1u << 20)
__device__ __forceinline__ unsigned xb_ld(unsigned* p)              { return __hip_atomic_load(p, __ATOMIC_RELAXED, __HIP_MEMORY_SCOPE_AGENT); }
__device__ __forceinline__ unsigned xb_add(unsigned* p, unsigned v) { return __hip_atomic_fetch_add(p, v, __ATOMIC_RELAXED, __HIP_MEMORY_SCOPE_AGENT); }
__device__ __forceinline__ unsigned xb_xcc_id() { return (unsigned)__builtin_amdgcn_s_getreg((3 << 11) | 20) & 0xFu; }
#define XB_SPIN(cond, bar) do { unsigned _sp = 0; while (cond) { __builtin_amdgcn_s_sleep(1); \
    if ((++_sp & 255u) == 0u) { if (xb_ld(&(bar)[XB_TMO])) break; if (_sp > XB_SPIN_CAP) { atomicAdd(&(bar)[XB_TMO], 1u); break; } } } } while (0)
struct XcdBarrier { unsigned* bar; unsigned x; volatile LAS unsigned* st; };
__device__ __forceinline__ XcdBarrier xcd_barrier_post(unsigned* bar, volatile LAS unsigned* st) {
    XcdBarrier b; b.bar = bar; b.x = xb_xcc_id(); b.st = st;
    if (threadIdx.x == 0) { st[2] = xb_add(&bar[XB_XCNT(b.x)], 1u); st[3] = b.x; }
    return b;
}
__device__ __forceinline__ void xcd_barrier_complete(unsigned* bar, unsigned x, unsigned& nloc, unsigned& nx) {
    const unsigned G = gridDim.x * gridDim.y * gridDim.z;
    unsigned sum, cnt, mine, sp = 0u;
    for (;;) {
        sum = 0u; cnt = 0u; mine = 0u;
#pragma unroll
        for (unsigned j = 0; j < 16; ++j) { const unsigned c = xb_ld(&bar[XB_XCNT(j)]); sum += c; cnt += (c > 0u) ? 1u : 0u; mine = (j == x) ? c : mine; }
        if (sum == G) break;
        __builtin_amdgcn_s_sleep(1);
        if ((++sp & 255u) == 0u) { if (xb_ld(&bar[XB_TMO])) break; if (sp > XB_SPIN_CAP) { atomicAdd(&bar[XB_TMO], 1u); break; } }
    }
    nloc = mine > 0u ? mine : 1u; nx = cnt > 0u ? cnt : 1u;
}
struct XbNop { __device__ __forceinline__ void operator()() const {} };
template <class F = XbNop>
__device__ __forceinline__ void xcd_barrier(const XcdBarrier& b, const F& idle_work = F()) {
    asm volatile("s_waitcnt vmcnt(0)" ::: "memory");
    __syncthreads();
    if (threadIdx.x >= 64) idle_work();
    if (threadIdx.x == 0) {
        unsigned* bar = b.bar;
        __builtin_amdgcn_s_waitcnt(0);
        unsigned nloc = b.st[0], nx = b.st[1];
        if (nloc == 0u) { xcd_barrier_complete(bar, b.x, nloc, nx); b.st[0] = nloc; b.st[1] = nx; }
        const unsigned old = xb_add(&bar[XB_XSUB(b.x)], 1u);
        const unsigned gen = old / nloc;
        if (old + 1u == (gen + 1u) * nloc) {
            __builtin_amdgcn_fence(__ATOMIC_RELEASE, "agent");
            asm volatile("s_waitcnt vmcnt(0)" ::: "memory");
            const unsigned og = xb_add(&bar[XB_TOP], 1u);
            const unsigned tg = og / nx;
            if (og + 1u == (tg + 1u) * nx) xb_add(&bar[XB_TOPGEN], 1u);
            else XB_SPIN(xb_ld(&bar[XB_TOPGEN]) == tg, bar);
            __builtin_amdgcn_fence(__ATOMIC_ACQUIRE, "agent");
            xb_add(&bar[XB_XGEN(b.x)], 1u);
            asm volatile("s_waitcnt vmcnt(0)" ::: "memory");
        } else {
            XB_SPIN(xb_ld(&bar[XB_XGEN(b.x)]) == gen, bar);
            __builtin_amdgcn_fence(__ATOMIC_ACQUIRE, "agent");
            asm volatile("s_waitcnt vmcnt(0)" ::: "memory");
        }
    }
    __syncthreads();
}

__device__ __forceinline__ void p0_transpose_item(const float* W, int K, int N, bf16_t* WT, LAS unsigned* scr, int kb, int nb, int lane) {
    const int k0 = 64 * kb, n0 = 64 * nb; const float* src = W + (size_t)k0 * N + n0; const int kp = lane >> 4, nc = (lane & 15) * 4;
#pragma unroll
    for (int j = 0; j < 8; ++j) { const int kk = 8 * j + 2 * kp;
        const f32x4 a = __builtin_nontemporal_load((const GAS f32x4*)(src + (size_t)kk * N + nc)), b = __builtin_nontemporal_load((const GAS f32x4*)(src + (size_t)(kk + 1) * N + nc));
        scr[(nc + 0) * 33 + (kk >> 1)] = pk2(a[0], b[0]); scr[(nc + 1) * 33 + (kk >> 1)] = pk2(a[1], b[1]);
        scr[(nc + 2) * 33 + (kk >> 1)] = pk2(a[2], b[2]); scr[(nc + 3) * 33 + (kk >> 1)] = pk2(a[3], b[3]); }
    LDS_WAIT(); asm volatile("" ::: "memory");
    const int c8 = lane & 7;
#pragma unroll
    for (int i = 0; i < 8; ++i) { const int n = (lane >> 3) + 8 * i; const LAS unsigned* s = scr + n * 33 + 4 * c8;
        u32x4 o; o.x = s[0]; o.y = s[1]; o.z = s[2]; o.w = s[3];
        *(GAS u32x4*)(WT + (size_t)(n0 + n) * K + k0 + 8 * c8) = o; }
    LDS_WAIT(); asm volatile("" ::: "memory");
}

__device__ __forceinline__ void p0_transpose_item_fp8(const float* W, int K, int N, unsigned char* WT, LAS unsigned* scr, int kb, int nb, int lane) {
    const int k0 = 128 * kb, n0 = 64 * nb; const float* src = W + (size_t)k0 * N + n0; const int nc = (lane & 15) * 4;
    LAS unsigned char* T = (LAS unsigned char*)scr;
    f32x4 a[2][16];
#pragma unroll
    for (int j = 0; j < 2; ++j)
#pragma unroll
        for (int q = 0; q < 16; ++q) a[j][q] = __builtin_nontemporal_load((const GAS f32x4*)(src + (size_t)(16 * (4 * j + (lane >> 4)) + q) * N + nc));
#pragma unroll
    for (int j = 0; j < 2; ++j) {
        const int k16 = 4 * j + (lane >> 4);
#pragma unroll
        for (int c = 0; c < 4; ++c) { unsigned w[4];
#pragma unroll
            for (int d = 0; d < 4; ++d) { int p = 0; p = __builtin_amdgcn_cvt_pk_fp8_f32(a[j][4 * d][c] * 64.f, a[j][4 * d + 1][c] * 64.f, p, false); p = __builtin_amdgcn_cvt_pk_fp8_f32(a[j][4 * d + 2][c] * 64.f, a[j][4 * d + 3][c] * 64.f, p, true); w[d] = (unsigned)p; }
            const int n = nc + c; *(LAS u32x4*)(T + n * 128 + ((k16 ^ ((n >> 2) & 7)) << 4)) = (u32x4){w[0], w[1], w[2], w[3]}; }
    }
    LDS_WAIT(); asm volatile("" ::: "memory");
    const int c8 = lane & 7;
#pragma unroll
    for (int i = 0; i < 8; ++i) { const int n = (lane >> 3) + 8 * i; const u32x4 o = *(const LAS u32x4*)(T + n * 128 + ((c8 ^ ((n >> 2) & 7)) << 4));
        __builtin_nontemporal_store(o, (GAS u32x4*)(WT + (size_t)(n0 + n) * K + k0 + 16 * c8)); }
    LDS_WAIT(); asm volatile("" ::: "memory");
}

constexpr int W_ITEMS = 8192 + 4096;
constexpr int P1_ITEMS = 11648;
__device__ __forceinline__ void conv_w_item(int t, const float* w1, const float* w2, unsigned char* W1T, unsigned char* W2T, LAS unsigned* scr, int lane) {
    if (t < 8192) { const int e = t >> 8, q = t & 255; p0_transpose_item_fp8(w1 + (size_t)e * 1024 * 2048, 1024, 2048, W1T + (size_t)e * 2048 * 1024, scr, q >> 5, q & 31, lane); }
    else { const int r = t - 8192, e = r >> 7, q = r & 127; p0_transpose_item_fp8(w2 + (size_t)e * 1024 * 1024, 1024, 1024, W2T + (size_t)e * 1024 * 1024, scr, q >> 4, q & 15, lane); }
}

struct Args { const float* in[16]; float* out; unsigned char* ws; };

__global__ void __launch_bounds__(512, 2) hymba_fwd(Args args) {
    extern __shared__ __attribute__((aligned(16))) unsigned char lds[];
    LAS unsigned char* L3 = (LAS unsigned char*)lds;
    const int tid = threadIdx.x, lane = tid & 63, wave = __builtin_amdgcn_readfirstlane(tid >> 6);
    const int G = gridDim.x; const int bx = blockIdx.x; const int vcu = (G % 8 == 0) ? (bx % 8) * (G / 8) + bx / 8 : bx;
    unsigned* ctl = (unsigned*)(args.ws + WS_CTL);
#define WSP(T, off) ((T*)(args.ws + (off)))
    for (int u = tid; u < (LDS_BYTES - RING_BYTES) / 4; u += 512) ((LAS unsigned*)(L3 + RING_BYTES))[u] = 0u;
    __syncthreads();
    XcdBarrier bar = xcd_barrier_post(ctl + CW_BAR, (volatile LAS unsigned*)(L3 + XT_MISC));
#define GRID_BAR() xcd_barrier(bar)
    const int gw = vcu * 8 + wave, NGW = G * 8;

    {
        LAS unsigned* scr = (LAS unsigned*)(L3 + wave * 16384);
        const float* x = args.in[0]; const float* attn_g = args.in[1]; const float* w_in = args.in[2]; const float* w_out = args.in[8]; const float* w_router = args.in[10]; const float* w1 = args.in[12]; const float* w2 = args.in[14];
        bf16_t* WIN = WSP(bf16_t, WS_WIN); bf16_t* WOUT = WSP(bf16_t, WS_WOUT); bf16_t* WRH = WSP(bf16_t, WS_WRH); bf16_t* WRL = WSP(bf16_t, WS_WRL); unsigned char* W1T = WSP(unsigned char, WS_W1); unsigned char* W2T = WSP(unsigned char, WS_W2); bf16_t* XN = WSP(bf16_t, WS_XN);
        constexpr int I_IN = 16 * 36, I_OUT = 16 * 16, NITEMS = I_IN + I_OUT + (W_ITEMS - P1_ITEMS);
        for (int it = gw; it < NITEMS; it += NGW) {
            int r = it;
            if (r < I_IN) { p0_transpose_item(w_in, 1024, NPROJ, WIN, scr, r / 36, r % 36, lane); continue; } r -= I_IN;
            if (r < I_OUT) { p0_transpose_item(w_out, 1024, 1024, WOUT, scr, r / 16, r % 16, lane); continue; } r -= I_OUT;
            conv_w_item(P1_ITEMS + r, w1, w2, W1T, W2T, scr, lane);
        }
        for (int m = gw; m < MTOK; m += 2 * NGW) {
            const int m2 = m + NGW;
            const GAS f32x4* xr = (const GAS f32x4*)(x + (size_t)m * DM) + lane; const GAS f32x4* xr2 = (const GAS f32x4*)(x + (size_t)m2 * DM) + lane; const GAS f32x4* gr = (const GAS f32x4*)attn_g + lane;
            f32x4 v[4], v2[4]; float s = 0.f, s2 = 0.f;
#pragma unroll
            for (int j = 0; j < 4; ++j) { v[j] = __builtin_nontemporal_load(xr + 64 * j); v2[j] = __builtin_nontemporal_load(xr2 + 64 * j); }
#pragma unroll
            for (int j = 0; j < 4; ++j) { s += (v[j][0] * v[j][0] + v[j][1] * v[j][1]) + (v[j][2] * v[j][2] + v[j][3] * v[j][3]); s2 += (v2[j][0] * v2[j][0] + v2[j][1] * v2[j][1]) + (v2[j][2] * v2[j][2] + v2[j][3] * v2[j][3]); }
            const float rstd = __builtin_amdgcn_rsqf(wave_sum(s) * (1.f / DM) + NORM_EPS), rstd2 = __builtin_amdgcn_rsqf(wave_sum(s2) * (1.f / DM) + NORM_EPS);
            GAS u32x2* o8 = (GAS u32x2*)(XN + (size_t)m * DM) + lane; GAS u32x2* o82 = (GAS u32x2*)(XN + (size_t)m2 * DM) + lane;
#pragma unroll
            for (int j = 0; j < 4; ++j) { const f32x4 g = gr[64 * j]; u32x2 o; o.x = pk2(v[j][0] * rstd * g[0], v[j][1] * rstd * g[1]); o.y = pk2(v[j][2] * rstd * g[2], v[j][3] * rstd * g[3]); o8[64 * j] = o;
                u32x2 o2; o2.x = pk2(v2[j][0] * rstd2 * g[0], v2[j][1] * rstd2 * g[1]); o2.y = pk2(v2[j][2] * rstd2 * g[2], v2[j][3] * rstd2 * g[3]); o82[64 * j] = o2; }
        }
        for (int i = vcu * 512 + tid; i < NE * 1024; i += G * 512) { const int e = i >> 10, k = i & 1023; const float wv = w_router[(size_t)k * NE + e]; const unsigned h = f2bf(wv);
            WRH[i] = (bf16_t)h; WRL[i] = (bf16_t)f2bf(wv - bf2f(h)); }
    }
    GRID_BAR();


    {
        const int q8 = bx >> 3, q16 = q8 & 15;
        if (q16 >= 9) {
            LAS unsigned* scr = (LAS unsigned*)(L3 + wave * 16384);
            const int cw = ((((q8 >> 4) * 7 + (q16 - 9)) * 8 + (bx & 7)) * 8) + wave;
            for (int t = cw; t < P1_ITEMS; t += 896) conv_w_item(t, args.in[12], args.in[14], WSP(unsigned char, WS_W1), WSP(unsigned char, WS_W2), scr, lane);
        } else {
            pg8::StaticOrder S; S.init(MTOK, NPROJ, 144, ((q8 >> 4) * 9 + q16) * 8 + (bx & 7), WSP(bf16_t, WS_XN), WSP(bf16_t, WS_WIN));
            pg8::EpiQKV E{WSP(bf16_t, WS_QKV), args.in[3], args.in[4], args.in[6], args.in[7]};
            pg8::gemm_phase<pg8::EpiQKV, pg8::StaticOrder, 2, false, false>(L3, S, E, 32u * 1024u * 2u);
        }
    }
    GRID_BAR();


    {
        const float* a_qg = args.in[3]; const float* a_kg = args.in[4]; const float* a_sinks = args.in[5]; const float* b_qg = args.in[6]; const float* b_kg = args.in[7];
        bf16_t* QKV = WSP(bf16_t, WS_QKV); bf16_t* OB = WSP(bf16_t, WS_OB); bf16_t* ATT = WSP(bf16_t, WS_ATT); float* LB = WSP(float, WS_LB);
        float ga = fabsf(a_qg[lane]), gb = fabsf(a_kg[lane]), gc = fabsf(b_qg[lane]), gd = fabsf(b_kg[lane]);
        ga = wave_max(ga); gb = wave_max(gb); gc = wave_max(gc); gd = wave_max(gd);
        const float boundA = 8.0f * LOG2E * ga * gb + 0.25f, boundB = 8.0f * LOG2E * gc * gd + 0.25f;
        LAS bf16_t* stg = (LAS bf16_t*)(L3 + 98304 + wave * 4096);
        LAS float* wsf = (LAS float*)(L3 + XT_IDX + wave * 128);
        for (int ui = 0; ui < 8; ++ui) {
            att::WU w; w.P = QKV;
            if (ui < 2) {
                const int ua = vcu * 2 + ui, b = ua >> 7, kvh = (ua >> 6) & 1, qb = ua & 63, head = kvh * 4 + (wave >> 1);
                w.seq0 = b * SEQ; w.dil = 1; w.L = SEQ; w.hw = 128; w.J0u = qb * 64 - 128; w.NTU = 10; w.U0 = qb * 64 + 32 * (wave & 1); w.toff = wave & 1;
                w.qcol = COL_QA + head * 64; w.kcol = COL_KA + kvh * 64; w.vcol = COL_VA + kvh * 64;
                w.slope2 = exp2f(-0.5f * (float)(head + 1)) * LOG2E; w.negc = -boundA; w.sinkp = exp2f(a_sinks[head] * LOG2E - boundA);
                w.O = ATT; w.opitch = DM; w.ocol = head * 64; w.lout = nullptr; w.lstride = 0; w.lcol = 0;
            } else {
                const int ub = vcu * 6 + (ui - 2), b = ub / 384, hb = (ub / 48) & 7, idx = ub % 48, br = idx >> 4, sub = idx & 15;
                int rho, qb;
                if (br == 0) { w.dil = 1; rho = 0; qb = sub; } else if (br == 1) { w.dil = 4; rho = sub >> 2; qb = sub & 3; } else { w.dil = 16; rho = sub; qb = 0; }
                w.seq0 = b * SEQ + rho; w.L = SEQ / w.dil; w.hw = 64; w.J0u = qb * 256 - 64; w.NTU = 12; w.U0 = qb * 256 + 32 * wave; w.toff = wave;
                w.qcol = COL_QB + hb * 64; w.kcol = COL_KB + hb * 64; w.vcol = COL_VB + hb * 64;
                w.slope2 = exp2f(-0.5f * (float)(8 + hb + 1)) * (float)w.dil * LOG2E; w.negc = -boundB; w.sinkp = 0.f;
                w.O = OB + (size_t)br * MTOK * 512; w.opitch = 512; w.ocol = hb * 64; w.lout = LB + (size_t)br * MTOK * 8; w.lstride = 8; w.lcol = hb;
            }
            att::load_unit(w, (char*)lds, wave, lane);
            asm volatile("s_waitcnt vmcnt(0)" ::: "memory");
            __syncthreads();
            f32x16 o[2]; float lsum;
            att::compute_unit(w, (char*)lds, o, lsum);
            att::store_unit(w, o, lsum, stg, wsf);
            __syncthreads();
        }
    }
    GRID_BAR();
    {
        bf16_t* OB = WSP(bf16_t, WS_OB); bf16_t* ATT = WSP(bf16_t, WS_ATT); float* LB = WSP(float, WS_LB);
        for (int it = vcu * 512 + tid; it < MTOK * 64; it += G * 512) {
            const int tok = it >> 6, hb = (it >> 3) & 7, ch = it & 7;
            float l[3]; u32x4 ov[3];
#pragma unroll
            for (int br = 0; br < 3; ++br) { l[br] = LB[(size_t)br * MTOK * 8 + (size_t)tok * 8 + hb]; ov[br] = __builtin_nontemporal_load((const u32x4*)(OB + (size_t)br * MTOK * 512 + (size_t)tok * 512 + hb * 64 + ch * 8)); }
            const float inv = 1.0f / (l[0] + l[1] + l[2]); const float w0 = l[0] * inv, w1_ = l[1] * inv, w2_ = l[2] * inv;
            unsigned ow[4];
#pragma unroll
            for (int q = 0; q < 4; ++q) { const unsigned a = ov[0][q], bq = ov[1][q], c = ov[2][q];
                const float lo = w0 * bf2f(a & 0xffffu) + w1_ * bf2f(bq & 0xffffu) + w2_ * bf2f(c & 0xffffu);
                const float hi = w0 * bf2f(a >> 16) + w1_ * bf2f(bq >> 16) + w2_ * bf2f(c >> 16); ow[q] = pk2(lo, hi); }
            *(u32x4*)(ATT + (size_t)tok * DM + 512 + hb * 64 + ch * 8) = (u32x4){ow[0], ow[1], ow[2], ow[3]};
        }
    }
    GRID_BAR();

    {
        pg8::StaticOrder S; S.init(MTOK, DM, G, bx, WSP(bf16_t, WS_ATT), WSP(bf16_t, WS_WOUT));
        pg8::EpiX1 E{args.in[0], WSP(float, WS_X1)};
        pg8::gemm_phase<pg8::EpiX1, pg8::StaticOrder, 0, false, false>(L3, S, E, 128u * 1024u * 2u);
    }
    GRID_BAR();


    {
        LAS int* hist = (LAS int*)(L3 + XT_HIST); LAS int* hbase = (LAS int*)(L3 + XT_BASE);
        const float* ffn_g = args.in[9]; const float* b_router = args.in[11]; const float* out = WSP(float, WS_X1);
        bf16_t* WRH = WSP(bf16_t, WS_WRH); bf16_t* WRL = WSP(bf16_t, WS_WRL); unsigned char* HN = WSP(unsigned char, WS_HN);
        float* RT = WSP(float, WS_RT); int* TOPE = WSP(int, WS_TOPE); int* TOPS = WSP(int, WS_TOPS); float* GATE = WSP(float, WS_GATE); int* LIST = WSP(int, WS_LIST);
        if (tid < 32) hist[tid] = 0;
        __syncthreads();
        const int r32 = lane & 31, hi = lane >> 5, grp = wave >> 2, kq = wave & 3;
        int te[4] = {0, 0, 0, 0}, tsl[4] = {0, 0, 0, 0}; float tg[4] = {0.f, 0.f, 0.f, 0.f};
        const int tok = vcu * 64 + grp * 32 + r32;
        LAS float* rstd_l = (LAS float*)(L3 + 101376);
        { f32x4 pa[8][4];
#pragma unroll
          for (int rr = 0; rr < 8; ++rr)
#pragma unroll
            for (int j = 0; j < 4; ++j) pa[rr][j] = ((const GAS f32x4*)(out + (size_t)(vcu * 64 + wave * 8 + rr) * DM) + lane)[64 * j];
#pragma unroll
          for (int rr = 0; rr < 8; ++rr) { float sq = 0.f;
#pragma unroll
            for (int j = 0; j < 4; ++j) { const f32x4 v = pa[rr][j]; sq += (v[0] * v[0] + v[1] * v[1]) + (v[2] * v[2] + v[3] * v[3]); }
            sq = wave_sum(sq); if (lane == 0) rstd_l[wave * 8 + rr] = __builtin_amdgcn_rsqf(sq * (1.f / DM) + NORM_EPS); } }
        __syncthreads();
        f32x16 acc = f32x16{};
        {
            constexpr int PITCH = 528;
            LAS unsigned char* XH = L3; LAS unsigned char* XL = L3 + 33792; LAS unsigned char* WH = L3 + 67584; LAS unsigned char* WL = L3 + 84480;
            f32x4 g4, xv[8]; u32x4 wv[4];
#define P4_LOAD(c) do { g4 = *(const f32x4*)(ffn_g + 256 * (c) + 4 * lane); \
                _Pragma("unroll") for (int rr = 0; rr < 8; ++rr) xv[rr] = *(const GAS f32x4*)(out + (size_t)(vcu * 64 + wave * 8 + rr) * DM + 256 * (c) + 4 * lane); \
                _Pragma("unroll") for (int i = 0; i < 2; ++i) { const int e = 4 * wave + 2 * i + (lane >> 5); wv[i] = *(const GAS u32x4*)(WRH + (size_t)e * 1024 + 256 * (c) + 8 * (lane & 31)); wv[2 + i] = *(const GAS u32x4*)(WRL + (size_t)e * 1024 + 256 * (c) + 8 * (lane & 31)); } } while (0)
            P4_LOAD(0);
            for (int c = 0; c < 4; ++c) {
#pragma unroll
                for (int rr = 0; rr < 8; ++rr) { const int row = wave * 8 + rr; const float rs = rstd_l[row];
                    const float v0 = xv[rr][0] * g4[0] * rs, v1 = xv[rr][1] * g4[1] * rs, v2 = xv[rr][2] * g4[2] * rs, v3 = xv[rr][3] * g4[3] * rs;
                    int p = 0; p = __builtin_amdgcn_cvt_pk_fp8_f32(v0, v1, p, false); p = __builtin_amdgcn_cvt_pk_fp8_f32(v2, v3, p, true);
                    *(GAS unsigned*)(HN + (size_t)(vcu * 64 + row) * DM + 256 * c + 4 * lane) = (unsigned)p;
                    const unsigned h01 = pk2(v0, v1), h23 = pk2(v2, v3);
                    *(LAS u32x2*)(XH + row * PITCH + 8 * lane) = (u32x2){h01, h23};
                    *(LAS u32x2*)(XL + row * PITCH + 8 * lane) = (u32x2){pk2(v0 - __builtin_bit_cast(float, h01 << 16), v1 - __builtin_bit_cast(float, h01 & 0xffff0000u)),
                                                                         pk2(v2 - __builtin_bit_cast(float, h23 << 16), v3 - __builtin_bit_cast(float, h23 & 0xffff0000u))}; }
#pragma unroll
                for (int i = 0; i < 2; ++i) { const int e = 4 * wave + 2 * i + (lane >> 5); *(LAS u32x4*)(WH + e * PITCH + 16 * (lane & 31)) = wv[i]; *(LAS u32x4*)(WL + e * PITCH + 16 * (lane & 31)) = wv[2 + i]; }
                __syncthreads();
                if (c < 3) P4_LOAD(c + 1);
#pragma unroll
                for (int ss = 0; ss < 4; ++ss) { const int ko = (16 * (kq * 4 + ss) + 8 * hi) * 2;
                    const bf16x8 xh = *(const LAS bf16x8*)(XH + (grp * 32 + r32) * PITCH + ko), xl = *(const LAS bf16x8*)(XL + (grp * 32 + r32) * PITCH + ko);
                    const bf16x8 wa = *(const LAS bf16x8*)(WH + r32 * PITCH + ko), wb = *(const LAS bf16x8*)(WL + r32 * PITCH + ko);
                    acc = __builtin_amdgcn_mfma_f32_32x32x16_bf16(wa, xh, acc, 0, 0, 0);
                    acc = __builtin_amdgcn_mfma_f32_32x32x16_bf16(wa, xl, acc, 0, 0, 0);
                    acc = __builtin_amdgcn_mfma_f32_32x32x16_bf16(wb, xh, acc, 0, 0, 0); }
                __syncthreads();
            }
#undef P4_LOAD
        }
        LAS float* red = (LAS float*)L3;
#pragma unroll
        for (int r = 0; r < 16; ++r) red[(wave * 17 + r) * 64 + lane] = acc[r];
        __syncthreads();
        if (kq == 0) {
#pragma unroll
            for (int q = 1; q < 4; ++q) {
#pragma unroll
                for (int r = 0; r < 16; ++r) acc[r] += red[((wave + q) * 17 + r) * 64 + lane]; }
            float lg[32];
#pragma unroll
            for (int r = 0; r < 16; ++r) { const float own = acc[r], oth = __shfl_xor(own, 32); const int e0 = (r & 3) + 8 * (r >> 2);
                const float v0 = hi ? oth : own, v1 = hi ? own : oth;
                lg[e0] = v0 + b_router[e0]; lg[e0 + 4] = v1 + b_router[e0 + 4]; }
            float tv[4];
#pragma unroll
            for (int kk = 0; kk < 4; ++kk) { float best = -INFINITY; int bi = 0;
#pragma unroll
                for (int e = 0; e < 32; ++e) { if (lg[e] > best) { best = lg[e]; bi = e; } }
#pragma unroll
                for (int e = 0; e < 32; ++e) { if (e == bi) lg[e] = -INFINITY; }
                tv[kk] = best; te[kk] = bi; }
            float ex[4], sum = 0.f;
#pragma unroll
            for (int kk = 0; kk < 4; ++kk) { ex[kk] = __expf(tv[kk] - tv[0]); sum += ex[kk]; }
#pragma unroll
            for (int kk = 0; kk < 4; ++kk) tg[kk] = ex[kk] / sum;
            if (hi == 0) {
#pragma unroll
                for (int kk = 0; kk < 4; ++kk) tsl[kk] = __hip_atomic_fetch_add(&hist[te[kk]], 1, __ATOMIC_RELAXED, __HIP_MEMORY_SCOPE_WORKGROUP);
            }
        }
        __syncthreads();
        if (tid < 32) hbase[tid] = (int)atomicAdd(ctl + CW_CNT + 64 * tid, (unsigned)hist[tid]);
        __syncthreads();
        if (kq == 0 && hi == 0) {
#pragma unroll
            for (int kk = 0; kk < 4; ++kk) { const int e = te[kk], slot = hbase[e] + tsl[kk]; LIST[(size_t)e * LISTCAP + slot] = tok; TOPE[tok * 4 + kk] = e; TOPS[tok * 4 + kk] = slot; GATE[tok * 4 + kk] = tg[kk]; }
        }
    }
    GRID_BAR();


    LAS int* tp = (LAS int*)(L3 + XT_TP); LAS int* cntl = (LAS int*)(L3 + XT_CNT); LAS int* ixt = (LAS int*)(L3 + XT_IDX);
    if (tid < NE) cntl[tid] = (int)__hip_atomic_load(ctl + CW_CNT + 64 * tid, RLX_AGENT);
    __syncthreads();
    if (tid == 0) { int acc_t = 0; for (int e = 0; e < NE; ++e) { tp[e] = acc_t; acc_t += (cntl[e] + 255) >> 8; } tp[NE] = acc_t; }
    __syncthreads();
    const int NTILES = __builtin_amdgcn_readfirstlane(tp[NE]);
    LAS int* xc = (LAS int*)(L3 + XT_MISC + 16);
    if (tid < 16) xc[tid] = (int)xb_ld(ctl + CW_BAR + XB_XCNT(tid));
    __syncthreads();
    int fq_, fn_, fr0_, fnr_;
    { const int myx = ((volatile LAS int*)(L3 + XT_MISC))[3]; int P = 0, n = 1;
      for (int j = 0; j < 16; ++j) { const int c = xc[j]; P += (j < myx) ? c : 0; n = (j == myx) ? c : n; }
      fq_ = __builtin_amdgcn_readfirstlane(((volatile LAS int*)(L3 + XT_MISC))[2]); fn_ = __builtin_amdgcn_readfirstlane(n); P = __builtin_amdgcn_readfirstlane(P);
      fr0_ = (NTILES * P) / G; fnr_ = (NTILES * (P + fn_)) / G - fr0_; }
    {
        int* LISTp = WSP(int, WS_LIST);
#pragma unroll
        for (int j = 0; j < 12; ++j) { const int idx = tid + 512 * j, i = idx >> 8, r = idx & 255; const int L = i * fn_ + fq_, L2 = L - fnr_ * 8;
            if (L2 < 0) { const int rt = fr0_ + (L >> 3); int e = 0; for (int q = 1; q < NE; ++q) e += (rt >= tp[q]) ? 1 : 0;
                const int n = cntl[e]; int sl = (rt - tp[e]) * 256 + r; sl = sl < n ? sl : n - 1; ixt[idx] = LISTp[(size_t)e * LISTCAP + sl]; }
            else if (L2 < fnr_ * 4) ixt[idx] = (fr0_ + (L2 >> 2)) * 256 + r; }
    }
    __syncthreads();

    {
        pg8::MoeFlow S; S.q = fq_; S.n = fn_; S.r0 = fr0_; S.nr = fnr_; S.tp = tp; S.ixt = ixt; S.ws = (const char*)args.ws; S.cnt = ctl + CW_RTC;
        pg8::EpiMoe E{pg8::EpiAct{WSP(unsigned char, WS_ACT), args.in[13]}, pg8::EpiY{WSP(unsigned char, WS_Y), args.in[15]}, ctl + CW_RTC};
        pg8::gemm_phase<pg8::EpiMoe, pg8::MoeFlow, 1, true, true, true>(L3, S, E, 0u);
    }
    {
        const float* x1p = WSP(float, WS_X1);
        auto pf = [&]() {
            const unsigned lb = (unsigned)(size_t)L3 + (unsigned)wave * 16384u;
#pragma unroll
            for (int t = 0; t < 4; ++t)
#pragma unroll
                for (int j = 0; j < 4; ++j) att::glds16(x1p + (size_t)(gw * 8 + t) * DM + j * 256 + lane * 4, lb + t * 4096 + j * 1024);
        };
        xcd_barrier(bar, pf);
    }
    asm volatile("s_waitcnt vmcnt(0)" ::: "memory");


    { float* out = args.out; int* TOPE = WSP(int, WS_TOPE); int* TOPS = WSP(int, WS_TOPS); float* GATE = WSP(float, WS_GATE); unsigned char* YB = WSP(unsigned char, WS_Y);
    for (int m0 = gw * 8; m0 < MTOK; m0 += NGW * 8) {
        int rowv = 0; float gatev = 0.f;
        if (lane < 32) { const int e = TOPE[m0 * 4 + lane], slot = TOPS[m0 * 4 + lane]; gatev = GATE[m0 * 4 + lane]; rowv = tp[e] * 256 + slot; }
#pragma unroll 2
        for (int t = 0; t < 8; ++t) {
            GAS f32x4* orow = (GAS f32x4*)(out + (size_t)(m0 + t) * DM) + lane; const GAS f32x4* xrow = (const GAS f32x4*)(WSP(float, WS_X1) + (size_t)(m0 + t) * DM) + lane;
            f32x4 v[4]; unsigned y[4][4]; float gt[4];
#pragma unroll
            for (int kk = 0; kk < 4; ++kk) { const int row = __shfl(rowv, t * 4 + kk); gt[kk] = __shfl(gatev, t * 4 + kk);
                const GAS unsigned* yr = (const GAS unsigned*)(YB + (size_t)row * DM) + lane;
#pragma unroll
                for (int j = 0; j < 4; ++j) y[kk][j] = __builtin_nontemporal_load(yr + 64 * j); }
            if (wave != 0 && m0 == gw * 8 && t < 4) {
#pragma unroll
                for (int j = 0; j < 4; ++j) v[j] = *(const LAS f32x4*)(L3 + wave * 16384 + t * 4096 + j * 1024 + lane * 16);
            } else {
#pragma unroll
                for (int j = 0; j < 4; ++j) v[j] = __builtin_nontemporal_load(xrow + 64 * j);
            }
#pragma unroll
            for (int kk = 0; kk < 4; ++kk)
#pragma unroll
                for (int j = 0; j < 4; ++j) { const f32x2 lo = __builtin_amdgcn_cvt_pk_f32_fp8((int)y[kk][j], false), hi2 = __builtin_amdgcn_cvt_pk_f32_fp8((int)y[kk][j], true);
                    v[j][0] += gt[kk] * lo[0]; v[j][1] += gt[kk] * lo[1]; v[j][2] += gt[kk] * hi2[0]; v[j][3] += gt[kk] * hi2[1]; }
#pragma unroll
            for (int j = 0; j < 4; ++j) __builtin_nontemporal_store(v[j], orow + 64 * j);
        }
    } }
}

extern "C" void kernel_launch(void* const* d_in, const int* in_sizes, int n_in, void* d_out, int out_size, void* d_ws, size_t ws_size, hipStream_t stream) {
    static int grid = 0;
    if (grid == 0) {
        if (n_in != 16 || out_size != MTOK * DM || ws_size < WS_END) { fprintf(stderr, "kernel_launch: unexpected shapes (n_in %d, out %d, ws %zu)\n", n_in, out_size, ws_size); grid = -1; return; }
        int dev = 0, cus = 0, per_cu = 0;
        if (hipGetDevice(&dev) != hipSuccess || hipDeviceGetAttribute(&cus, hipDeviceAttributeMultiprocessorCount, dev) != hipSuccess) { grid = -1; return; }
        if (hipFuncSetAttribute((const void*)hymba_fwd, hipFuncAttributeMaxDynamicSharedMemorySize, LDS_BYTES) != hipSuccess) { fprintf(stderr, "kernel_launch: hipFuncSetAttribute failed\n"); grid = -1; return; }
        if (hipOccupancyMaxActiveBlocksPerMultiprocessor(&per_cu, (const void*)hymba_fwd, 512, LDS_BYTES) != hipSuccess || per_cu < 1) { fprintf(stderr, "kernel_launch: occupancy query reports %d blocks per CU\n", per_cu); per_cu = 1; }
        (void)hipGetLastError();
        grid = cus;
        if (grid != 256) fprintf(stderr, "kernel_launch: %d CUs; the attention phase assumes 256 workgroups\n", grid);
    }
    if (grid < 0) return;
    (void)hipMemsetAsync((char*)d_ws + WS_CTL, 0, CTL_ZERO_BYTES, stream);
    Args a{};
    for (int i = 0; i < 16; ++i) a.in[i] = (const float*)d_in[i];
    a.out = (float*)d_out; a.ws = (unsigned char*)d_ws;
    void* params[] = {&a};
    hipError_t e = hipLaunchCooperativeKernel((const void*)hymba_fwd, dim3(grid), dim3(512), params, LDS_BYTES, stream);
    if (e != hipSuccess) fprintf(stderr, "kernel_launch: cooperative launch failed: %s (grid %d)\n", hipGetErrorString(e), grid);
}
```

```cpp
#include <hip/hip_runtime.h>
#include <hip/hip_bf16.h>
#include <cstdio>
#include <cstdint>

#define LAS __attribute__((address_space(3)))
#define GAS __attribute__((address_space(1)))
typedef unsigned short bf16_t;
typedef short bf16x8 __attribute__((ext_vector_type(8)));
typedef short s16x4 __attribute__((ext_vector_type(4)));
typedef float f32x4 __attribute__((ext_vector_type(4)));
typedef float f32x2 __attribute__((ext_vector_type(2)));
typedef float f32x16 __attribute__((ext_vector_type(16)));
typedef unsigned u32x4 __attribute__((ext_vector_type(4)));
typedef unsigned u32x2 __attribute__((ext_vector_type(2)));

constexpr int BATCH = 4, SEQ = 4096, DM = 1024, MTOK = BATCH * SEQ;
constexpr int HD = 64, NPROJ = 2304;
constexpr int COL_QA = 0, COL_KA = 512, COL_VA = 640, COL_QB = 768, COL_KB = 1280, COL_VB = 1792;
constexpr int NE = 32, TOPK = 4, DFF = 1024;
constexpr float NORM_EPS = 1e-5f;
constexpr float LOG2E = 1.4426950408889634f;
constexpr float C2 = 0.125f * LOG2E;
constexpr int LISTCAP = MTOK;

constexpr size_t MiB = 1u << 20;
constexpr size_t WS_CTL = 0, CTL_ZERO_BYTES = 1 * MiB;
constexpr size_t WS_WIN = 2 * MiB;
constexpr size_t WS_WOUT = 8 * MiB;
constexpr size_t WS_WRH = 10 * MiB;
constexpr size_t WS_WRL = 10 * MiB + 65536;
constexpr size_t WS_RT = 11 * MiB;
constexpr size_t WS_TOPE = 11 * MiB + 65536;
constexpr size_t WS_TOPS = WS_TOPE + 262144;
constexpr size_t WS_GATE = WS_TOPS + 262144;
constexpr size_t WS_LIST = 12 * MiB;
constexpr size_t WS_LB = 14 * MiB;
constexpr size_t WS_W1 = 16 * MiB;
constexpr size_t WS_W2 = 144 * MiB;
constexpr size_t WS_XN = 208 * MiB;
constexpr size_t WS_QKV = 240 * MiB;
constexpr size_t WS_OB = 312 * MiB;
constexpr size_t WS_ATT = 360 * MiB;
constexpr size_t WS_HN = 392 * MiB;
constexpr size_t WS_ACT = 424 * MiB;
constexpr size_t WS_Y = 568 * MiB;
constexpr size_t WS_X1 = 712 * MiB;
constexpr size_t WS_END = 776 * MiB;
constexpr int CW_BAR = 4096;
constexpr int CW_CNT = 16384;
constexpr int CW_RT3 = 49152;
constexpr int CW_P2 = 57344;
constexpr int CW_RTC = 32768;

constexpr int RING_BYTES = 131072;
constexpr int XT_IDX = RING_BYTES;
constexpr int XT_TP = XT_IDX + 24576;
constexpr int XT_CNT = XT_TP + 160;
constexpr int XT_HIST = XT_CNT + 128;
constexpr int XT_BASE = XT_HIST + 128;
constexpr int XT_MISC = XT_BASE + 128;
constexpr int XT_BIAS = XT_MISC + 128;
constexpr int LDS_BYTES = 159744;
static_assert(XT_BIAS + 2048 <= LDS_BYTES, "LDS map");

#define RLX_AGENT __ATOMIC_RELAXED, __HIP_MEMORY_SCOPE_AGENT
#define LDS_WAIT() asm volatile("s_waitcnt lgkmcnt(0)" ::: "memory")
#define VM_WAIT() asm volatile("s_waitcnt vmcnt(0)" ::: "memory")

__device__ __forceinline__ unsigned f2bf(float f) { unsigned u = __builtin_bit_cast(unsigned, f); return (u + 0x7fffu + ((u >> 16) & 1u)) >> 16; }
__device__ __forceinline__ unsigned pk2(float lo, float hi) { unsigned r; asm volatile("v_cvt_pk_bf16_f32 %0, %1, %2" : "=v"(r) : "v"(lo), "v"(hi)); return r; }
__device__ __forceinline__ float bf2f(unsigned h) { return __builtin_bit_cast(float, h << 16); }
__device__ __forceinline__ unsigned cvt_pk_bf16(float lo, float hi) { unsigned r; asm volatile("v_cvt_pk_bf16_f32 %0, %1, %2" : "=v"(r) : "v"(lo), "v"(hi)); return r; }
__device__ __forceinline__ float wave_sum(float v) {
#pragma unroll
    for (int o = 1; o < 64; o <<= 1) v += __shfl_xor(v, o);
    return v;
}
__device__ __forceinline__ float wave_max(float v) {
#pragma unroll
    for (int o = 1; o < 64; o <<= 1) v = fmaxf(v, __shfl_xor(v, o));
    return v;
}

namespace pg8 {
constexpr int BM = 256, BK = 64, HALF = 128, HTB = HALF * BK * 2, KDIM = 1024;
__host__ __device__ __forceinline__ int lds_byte(int r, int c) { const int st = (r >> 4) * 2 + (c >> 5), rr = r & 15, cc = c & 31, ob = rr * 64 + cc * 2; return st * 1024 + (ob ^ (((ob >> 9) & 1) << 5)); }
__host__ __device__ __forceinline__ void stage_rc(int b, int& R, int& C) { const int st = b / 1024, sb = b % 1024, swz = sb ^ (((sb >> 9) & 1) << 5); R = (st >> 1) * 16 + swz / 64; C = (st & 1) * 32 + (swz % 64) / 2; }
__host__ __device__ __forceinline__ int perm32(int rho) { const int n = rho >> 4, i = rho & 15; return 8 * (i >> 2) + 4 * n + (i & 3); }

struct UnitD { const char* A; const char* B; int pm, pn, e, ui, kind; unsigned bh; };

typedef int v8i __attribute__((ext_vector_type(8)));
typedef int v4i __attribute__((ext_vector_type(4)));
__device__ __forceinline__ void glds16p(const void* gsrc, unsigned lds_dst) { unsigned keep;
    asm volatile("s_mov_b32 %0, m0\n\ts_mov_b32 m0, %2\n\ts_nop 0\n\tglobal_load_lds_dwordx4 %1, off\n\ts_mov_b32 m0, %0" : "=&s"(keep) : "v"(gsrc), "s"(lds_dst) : "memory"); }
__device__ __forceinline__ void glds4_sc1(const void* gsrc, unsigned lds_dst) { unsigned keep;
    asm volatile("s_mov_b32 %0, m0\n\ts_mov_b32 m0, %2\n\ts_nop 0\n\tglobal_load_lds_dword %1, off sc1\n\ts_mov_b32 m0, %0" : "=&s"(keep) : "v"(gsrc), "s"(lds_dst) : "memory"); }
template <class Epi, class Sched, int BMODE, bool GATHER, bool FP8, bool FLOW = false>
__device__ __forceinline__ void gemm_phase(LAS unsigned char* lds, const Sched& S, const Epi& E, const unsigned bhstep) {
    constexpr int ROWB = FP8 ? 1024 : 2048, nt = FP8 ? 8 : 16;
    const int tid = threadIdx.x, wid = __builtin_amdgcn_readfirstlane(tid >> 6), lane = tid & 63, wr = wid >> 2, wc = wid & 3, fr = lane & 15, fq = lane >> 4;
    unsigned voffA[GATHER ? 2 : 1][2], voffB[2];
#pragma unroll
    for (int i = 0; i < 2; ++i) { int R, C; stage_rc(tid * 16 + i * 8192, R, C);
        const int Rb = BMODE == 0 ? R : (BMODE == 1 ? ((R & ~31) + perm32(R & 31)) : (2 * (R & ~31) + perm32(R & 31)));
        voffB[i] = (unsigned)(Rb * ROWB + C * 2);
        voffA[0][i] = (unsigned)(R * ROWB + C * 2); if constexpr (GATHER) voffA[1][i] = 0u; }
    int sclX = 0x7F7F7F7F; asm volatile("" : "+v"(sclX));
    const size_t kstep = (size_t)(BK * 2);
    const unsigned ldsw = (unsigned)wid * 1024u;
    const int aoff = lds_byte(wr * 64 + fr, fq * 8), boff = lds_byte(wc * 32 + fr, fq * 8);
    LAS unsigned char* Ap = lds + aoff; LAS unsigned char* Bp = lds + boff + 4 * HTB;
    asm volatile("" : "+v"(Ap)); asm volatile("" : "+v"(Bp));
#define PG8_SA(b, h) (((b) * 2 + (h)) * HTB)
#define PG8_SB(b, h) ((4 + (b) * 2 + (h)) * HTB)
#define PG8_STAGE_X(bufoff, gbase, voff, AUX) do { _Pragma("unroll") for (int _i = 0; _i < 2; ++_i) \
        __builtin_amdgcn_global_load_lds((const unsigned*)((const char*)(gbase) + (voff)[_i]), (LAS unsigned*)(lds + (bufoff) + ldsw + _i * 8192), 16, 0, AUX); } while (0)
#define PG8_STAGE(bufoff, gbase, voff) PG8_STAGE_X(bufoff, gbase, voff, 0)
#define PG8_STAGE_A(b, h, gbase) do { if constexpr (GATHER) { PG8_STAGE(PG8_SA(b, h), gbase, voffA[h]); } else { PG8_STAGE(PG8_SA(b, h), (gbase) + (h) * (HALF * ROWB), voffA[0]); } } while (0)
#define PG8_RDA(off) (*(const LAS v4i*)(Ap + (off)))
#define PG8_RDB(off) (*(const LAS v4i*)(Bp + (off)))
#define PG8_LDA(dst, b, h) do { _Pragma("unroll") for (int m = 0; m < 4; ++m) { if constexpr (FP8) dst##8[m] = __builtin_shufflevector(PG8_RDA(PG8_SA(b, h) + m * 2048), PG8_RDA(PG8_SA(b, h) + m * 2048 + 1024), 0, 1, 2, 3, 4, 5, 6, 7); \
        else { _Pragma("unroll") for (int k = 0; k < 2; ++k) dst[m][k] = __builtin_bit_cast(bf16x8, PG8_RDA(PG8_SA(b, h) + m * 2048 + k * 1024)); } } } while (0)
#define PG8_LDB(dst, b, h) do { _Pragma("unroll") for (int n = 0; n < 2; ++n) { if constexpr (FP8) dst##8[n] = __builtin_shufflevector(PG8_RDB(PG8_SA(b, h) + n * 2048), PG8_RDB(PG8_SA(b, h) + n * 2048 + 1024), 0, 1, 2, 3, 4, 5, 6, 7); \
        else { _Pragma("unroll") for (int k = 0; k < 2; ++k) dst[n][k] = __builtin_bit_cast(bf16x8, PG8_RDB(PG8_SA(b, h) + n * 2048 + k * 1024)); } } } while (0)
#define PG8_MMA(ai, bj, At, Bt) do { __builtin_amdgcn_s_setprio(1); _Pragma("unroll") for (int m = 0; m < 4; ++m) _Pragma("unroll") for (int n = 0; n < 2; ++n) { \
        if constexpr (FP8) { acc[ai][bj][m][n] = __builtin_amdgcn_mfma_scale_f32_16x16x128_f8f6f4(Bt##8[n], At##8[m], acc[ai][bj][m][n], 0, 0, 0, sclX, 0, sclX); } \
        else { _Pragma("unroll") for (int k = 0; k < 2; ++k) acc[ai][bj][m][n] = __builtin_amdgcn_mfma_f32_16x16x32_bf16(Bt[n][k], At[m][k], acc[ai][bj][m][n], 0, 0, 0); } } \
        __builtin_amdgcn_s_setprio(0); } while (0)
#define PG8_WAIT_V(n) asm volatile("s_waitcnt vmcnt(" #n ")" ::: "memory")
#define PG8_WAIT_L(n) asm volatile("s_waitcnt lgkmcnt(" #n ")" ::: "memory")
#define PG8_BAR __builtin_amdgcn_s_barrier()
#define PG8_SCHED __builtin_amdgcn_sched_barrier(0)
#define PG8_GIDX(uord, U) do { if constexpr (GATHER) { const LAS int* _ix = S.idx(uord); _Pragma("unroll") for (int _i = 0; _i < 2; ++_i) { int R, C; stage_rc(tid * 16 + _i * 8192, R, C); \
        voffA[0][_i] = (unsigned)(_ix[R] * ROWB + C * 2); voffA[1][_i] = (unsigned)(_ix[R + HALF] * ROWB + C * 2); } } } while (0)
#define PG8_DEPSPIN(rt, c0) do { unsigned _c = (c0), _sp = 0; const unsigned* _p = S.cnt + (rt) * 16; \
        while (_c < 64u && ++_sp < (1u << 18)) { __builtin_amdgcn_s_sleep(2); unsigned _t; asm volatile("global_load_dword %0, %1, %2 sc1\n\ts_waitcnt vmcnt(0)" : "=v"(_t) : "v"(0), "s"(_p) : "memory"); _c = (unsigned)__builtin_amdgcn_readfirstlane(_t); } } while (0)
    UnitD cur, nxt; int ui = 0;
    if (!S.next(0, cur)) return;
    f32x4 acc[2][2][4][2];
#pragma unroll
    for (int a = 0; a < 2; ++a)
#pragma unroll
        for (int b = 0; b < 2; ++b)
#pragma unroll
            for (int m = 0; m < 4; ++m)
#pragma unroll
                for (int n = 0; n < 2; ++n) acc[a][b][m][n] = (f32x4){0.f, 0.f, 0.f, 0.f};
    bf16x8 At[FP8 ? 1 : 4][2], B0[2][2], B1[2][2]; v8i At8[4], B08[2], B18[2];
    const char* cA = cur.A; const char* cB = cur.B; unsigned cbh = bhstep; if constexpr (FLOW) cbh = cur.bh;
    const unsigned dslot = (unsigned)(size_t)(lds + XT_MISC + 96) + (unsigned)wid * 4u; int rtp = 0;
    if constexpr (FLOW) {
#pragma unroll
        for (int k = 0; k < 3; ++k) { int rt_; if (S.dep(k, rt_)) PG8_DEPSPIN(rt_, 0u); }
        if (lane == 0) asm volatile("ds_write_b32 %0, %1" :: "v"(dslot), "v"(64u) : "memory");
    }
    if constexpr (FLOW) { if (wid == 0) E.bias_prefetch(cur, lane); }
    PG8_GIDX(0, cur);
    PG8_STAGE(PG8_SB(0, 0), cB, voffB); PG8_STAGE(PG8_SB(0, 1), cB + cbh, voffB); PG8_STAGE_A(0, 0, cA); PG8_STAGE_A(0, 1, cA);
    if (wr == 1) PG8_BAR;
    PG8_WAIT_V(2); PG8_BAR;
    PG8_STAGE(PG8_SB(1, 0), cB + kstep, voffB); PG8_STAGE_A(1, 0, cA + kstep); PG8_STAGE(PG8_SB(1, 1), cB + cbh + kstep, voffB);
    PG8_WAIT_V(6); PG8_BAR;
    for (;;) {
        const bool has_next = S.next(ui + 1, nxt);
        const char* nA = has_next ? nxt.A : cA; const char* nB = has_next ? nxt.B : cB; unsigned nbh = cbh; if constexpr (FLOW) nbh = has_next ? nxt.bh : cbh;
#pragma clang loop unroll(disable)
        for (int t = 0; t < nt; t += 2) {
            const bool last = (t == nt - 2);
            const char* a1 = cA + (size_t)(t + 1) * kstep;
            const char* a2 = last ? nA : cA + (size_t)(t + 2) * kstep; const char* b2 = last ? nB : cB + (size_t)(t + 2) * kstep;
            const char* a3 = a2 + kstep; const char* b3 = b2 + kstep; const unsigned bh2 = (FLOW && last) ? nbh : cbh;
            PG8_LDB(B0, 0, 0); PG8_LDB(B1, 0, 1); PG8_SCHED; PG8_LDA(At, 0, 0); PG8_STAGE_A(1, 1, a1);
            if (GATHER && last && has_next) { PG8_GIDX(ui + 1, nxt); }
            PG8_WAIT_V(8); PG8_WAIT_L(0); PG8_BAR; PG8_MMA(0, 0, At, B0); PG8_MMA(0, 1, At, B1); PG8_BAR; PG8_SCHED;
            PG8_LDA(At, 0, 1); PG8_STAGE(PG8_SB(0, 0), b2, voffB); PG8_STAGE(PG8_SB(0, 1), b2 + bh2, voffB); PG8_STAGE_A(0, 0, a2);
            PG8_WAIT_V(8); PG8_WAIT_L(0); PG8_BAR; PG8_MMA(1, 0, At, B0); PG8_MMA(1, 1, At, B1); PG8_BAR; PG8_SCHED;
            PG8_LDB(B0, 1, 0); PG8_LDB(B1, 1, 1); PG8_SCHED; PG8_LDA(At, 1, 0); PG8_STAGE_A(0, 1, a2);
            PG8_WAIT_V(8); PG8_WAIT_L(0); PG8_BAR; PG8_MMA(0, 0, At, B0); PG8_MMA(0, 1, At, B1); PG8_BAR; PG8_SCHED;
            PG8_LDA(At, 1, 1); PG8_STAGE(PG8_SB(1, 0), b3, voffB); PG8_STAGE(PG8_SB(1, 1), b3 + bh2, voffB); PG8_STAGE_A(1, 0, a3);
            PG8_WAIT_V(8); PG8_WAIT_L(0); PG8_BAR; PG8_MMA(1, 0, At, B0); PG8_MMA(1, 1, At, B1); PG8_BAR; PG8_SCHED;
        }
        if (wr == 0) PG8_BAR;
        if constexpr (FLOW) { if (wid == 0 && has_next) E.bias_prefetch(nxt, lane); }
        unsigned cdep = 64u; int rt3 = 0;
        if constexpr (FLOW) { unsigned cv; asm volatile("ds_read_b32 %0, %1\n\ts_waitcnt lgkmcnt(0)" : "=v"(cv) : "v"(dslot) : "memory"); cdep = (unsigned)__builtin_amdgcn_readfirstlane(cv);
            const bool d3 = S.dep(ui + 3, rt3);
            if (lane == 0) { if (d3) glds4_sc1(S.cnt + rt3 * 16, dslot); else asm volatile("ds_write_b32 %0, %1" :: "v"(dslot), "v"(64u) : "memory"); } }
        { int l2; asm volatile("v_mbcnt_lo_u32_b32 %0, -1, 0\n\tv_mbcnt_hi_u32_b32 %0, -1, %0" : "=v"(l2)); E(acc, cur, wr, wc, l2 & 15, l2 >> 4); }
        if constexpr (FLOW) {
            if (cur.kind == 0) { if (lane == 0) (void)__hip_atomic_fetch_add(S.cnt + cur.pm * 16, 1u, RLX_AGENT); }
            { const bool xin = (S.nd != S.ndo && rtp == S.rin); PG8_DEPSPIN(rtp, xin ? 0u : cdep); }
            rtp = rt3; }
        if (!has_next) break;
#pragma unroll
        for (int a = 0; a < 2; ++a)
#pragma unroll
            for (int b = 0; b < 2; ++b)
#pragma unroll
                for (int m = 0; m < 4; ++m)
#pragma unroll
                    for (int n = 0; n < 2; ++n) acc[a][b][m][n] = (f32x4){0.f, 0.f, 0.f, 0.f};
        cur = nxt; cA = nA; cB = nB; cbh = nbh; ++ui;
        if (wr == 1) PG8_BAR;
    }
    PG8_WAIT_V(0);
    PG8_BAR;
#undef PG8_SA
#undef PG8_SB
#undef PG8_STAGE
#undef PG8_LDA
#undef PG8_LDB
#undef PG8_MMA
#undef PG8_RDA
#undef PG8_STAGE_A
#undef PG8_RDB
#undef PG8_WAIT_V
#undef PG8_WAIT_L
#undef PG8_BAR
#undef PG8_SCHED
#undef PG8_GIDX
#undef PG8_DEPSPIN
#undef PG8_STAGE_X
}

struct StaticOrder {
    int nM, nN, nwg, G, c; const char* A; const char* B; const LAS int* ix;
    __device__ void init(int M, int N, int G_, int c_, const void* A_, const void* B_) { nM = M / BM; nN = N / BM; nwg = nM * nN; G = G_; c = c_; A = (const char*)A_; B = (const char*)B_; ix = nullptr; }
    __device__ __forceinline__ bool next(int i, UnitD& u) const {
        const long L = (long)i * G + c; if (L >= nwg) return false;
        int wgid = (int)L; { const int q = nwg / 8, r = nwg % 8, xcd = wgid % 8, off = wgid / 8; wgid = (xcd < r ? xcd * (q + 1) : r * (q + 1) + (xcd - r) * q) + off; }
        const int WGM = 4, nig = WGM * nN, gid = wgid / nig, fm = gid * WGM, gsz = (nM - fm) < WGM ? (nM - fm) : WGM;
        u.pm = fm + ((wgid % nig) % gsz); u.pn = (wgid % nig) / gsz; u.e = 0; u.ui = i;
        u.A = A + (size_t)u.pm * (BM * KDIM * 2); u.B = B + (size_t)u.pn * (BM * KDIM * 2); return true;
    }
    __device__ __forceinline__ const LAS int* idx(int) const { return ix; }
};

__device__ __forceinline__ bool moe_unit(int i, int vcu, int NT, int ncol, int& rt, int& pn) {
    const int x = vcu >> 5, u = i * 32 + (vcu & 31), r0 = (x * NT) >> 3, r1 = ((x + 1) * NT) >> 3, rl = u / ncol;
    if (rl >= r1 - r0) return false;
    rt = r0 + rl; pn = u - rl * ncol; return true;
}
struct MoeOrder {
    int G, vcu, ncol, NT; const LAS int* tp; const LAS int* ixt; const char* A; const char* B; size_t bexp, bcol, astride; bool gather;
    __device__ __forceinline__ bool next(int i, UnitD& u) const {
        int rt, pn; if (!moe_unit(i, vcu, NT, ncol, rt, pn)) return false;
        int e = 0;
        for (int j = 1; j < NE; ++j) e += (rt >= tp[j]) ? 1 : 0;
        e = __builtin_amdgcn_readfirstlane(e);
        u.pm = rt; u.pn = pn; u.e = e; u.ui = i;
        u.A = gather ? A : A + (size_t)rt * astride;
        u.B = B + (size_t)e * bexp + (size_t)pn * bcol; return true;
    }
    __device__ __forceinline__ const LAS int* idx(int uord) const { return ixt + uord * 256; }
};

struct MoeFlow {
    int q, n, r0, nr, ndo, nd, rin; const LAS int* tp; const LAS int* ixt; const char* ws; unsigned* cnt;
    __device__ __forceinline__ bool next(int i, UnitD& u) const {
        const int L = i * n + q, n5 = nr * 8; int kind, rt, pn;
        if (L < n5) { kind = 0; rt = r0 + (L >> 3); pn = L & 7; } else { const int L2 = L - n5; if (L2 >= nd) return false; kind = 1; rt = L2 < ndo ? r0 + (L2 >> 2) : rin; pn = L2 & 3; }
        const int ln = threadIdx.x & 63;
        const int e = __builtin_popcountll(__builtin_amdgcn_ballot_w64(ln < NE - 1 && rt >= tp[ln < NE - 1 ? ln + 1 : NE]));
        u.pm = rt; u.pn = pn; u.e = e; u.ui = i; u.kind = kind;
        u.A = ws + (kind ? WS_ACT : WS_HN); u.bh = kind ? 128u * 1024u : 1024u * 1024u;
        u.B = ws + (kind ? WS_W2 + (size_t)e * (1024 * 1024) + (size_t)pn * (256 * 1024) : WS_W1 + (size_t)e * (2048 * 1024) + (size_t)pn * (128 * 1024)); return true;
    }
    __device__ __forceinline__ const LAS int* idx(int uord) const { return ixt + uord * 256; }
    __device__ __forceinline__ bool dep(int i, int& rt) const { const int L2 = i * n + q - nr * 8; rt = L2 < ndo ? r0 + (L2 >> 2) : rin; return L2 >= 0 && L2 < nd; }
};

struct EpiQKV {
    bf16_t* O; const float *gqa, *gka, *gqb, *gkb;
    __device__ __forceinline__ void operator()(const f32x4 (&acc)[2][2][4][2], const UnitD& u, int wr, int wc, int fr, int fq) const {
        const int head = 4 * u.pn + wc; const float* g = nullptr; float sc = 1.f;
        if (head < 8) { g = gqa; sc = C2; } else if (head < 10) { g = gka; } else if (head < 12) { g = nullptr; } else if (head < 20) { g = gqb; sc = C2; } else if (head < 28) { g = gkb; }
        f32x4 gv[2][2];
        { const float* gp = g ? g : gqa; const float gm = g ? sc : 0.f, ga = g ? 0.f : 1.f;
#pragma unroll
          for (int bj = 0; bj < 2; ++bj)
#pragma unroll
            for (int n = 0; n < 2; ++n) gv[bj][n] = *(const f32x4*)(gp + 32 * bj + 8 * fq + 4 * n);
#pragma unroll
          for (int bj = 0; bj < 2; ++bj)
#pragma unroll
            for (int n = 0; n < 2; ++n) gv[bj][n] = gv[bj][n] * gm + ga; }
        const int row0 = u.pm * BM + wr * 64 + fr, col0 = u.pn * BM + wc * 64 + 8 * fq;
#pragma unroll
        for (int ai = 0; ai < 2; ++ai)
#pragma unroll
            for (int m = 0; m < 4; ++m) {
                float rs = 1.f;
                if (g) { float ss = 0.f;
#pragma unroll
                    for (int bj = 0; bj < 2; ++bj)
#pragma unroll
                        for (int n = 0; n < 2; ++n) { const f32x4 v = acc[ai][bj][m][n]; ss += (v[0] * v[0] + v[1] * v[1]) + (v[2] * v[2] + v[3] * v[3]); }
                    ss += __shfl_xor(ss, 16); ss += __shfl_xor(ss, 32);
                    rs = __builtin_amdgcn_rsqf(ss * (1.f / 64.f) + NORM_EPS); }
                bf16_t* rowp = O + (size_t)(row0 + ai * HALF + m * 16) * NPROJ + col0;
#pragma unroll
                for (int bj = 0; bj < 2; ++bj) { const f32x4 v0 = acc[ai][bj][m][0] * rs * gv[bj][0], v1 = acc[ai][bj][m][1] * rs * gv[bj][1];
                    u32x4 w; w.x = cvt_pk_bf16(v0[0], v0[1]); w.y = cvt_pk_bf16(v0[2], v0[3]); w.z = cvt_pk_bf16(v1[0], v1[1]); w.w = cvt_pk_bf16(v1[2], v1[3]);
                    *(u32x4*)(rowp + bj * 32) = w; }
            }
    }
};
struct EpiX1 {
    const float* base; float* out;
    __device__ __forceinline__ void operator()(const f32x4 (&acc)[2][2][4][2], const UnitD& u, int wr, int wc, int fr, int fq) const {
        const int col0 = u.pn * BM + wc * 32 + 4 * fq;
#pragma unroll
        for (int ai = 0; ai < 2; ++ai) { f32x4 bs[4][2][2];
#pragma unroll
            for (int m = 0; m < 4; ++m) { const size_t off = (size_t)(u.pm * BM + ai * HALF + wr * 64 + m * 16 + fr) * DM + col0;
#pragma unroll
                for (int bj = 0; bj < 2; ++bj)
#pragma unroll
                    for (int n = 0; n < 2; ++n) bs[m][bj][n] = __builtin_nontemporal_load((const f32x4*)(base + off + bj * HALF + n * 16)); }
#pragma unroll
            for (int m = 0; m < 4; ++m) { const size_t off = (size_t)(u.pm * BM + ai * HALF + wr * 64 + m * 16 + fr) * DM + col0;
#pragma unroll
                for (int bj = 0; bj < 2; ++bj)
#pragma unroll
                    for (int n = 0; n < 2; ++n) *(f32x4*)(out + off + bj * HALF + n * 16) = bs[m][bj][n] + acc[ai][bj][m][n]; } }
    }
};
struct EpiX1F {
    EpiX1 e; unsigned* cnt;
    __device__ __forceinline__ void operator()(const f32x4 (&acc)[2][2][4][2], const UnitD& u, int wr, int wc, int fr, int fq) const {
        e(acc, u, wr, wc, fr, fq); asm volatile("s_waitcnt vmcnt(0)" ::: "memory");
        if ((fr | fq) == 0) (void)__hip_atomic_fetch_add(cnt + u.pm * 16, 1u, RLX_AGENT);
    }
};
struct RowOrder {
    int nwg, G, c; const char* A; const char* B;
    __device__ __forceinline__ bool next(int i, UnitD& u) const {
        const int L = i * G + c; if (L >= nwg) return false;
        u.pm = L >> 2; u.pn = L & 3; u.e = 0; u.ui = i;
        u.A = A + (size_t)u.pm * (BM * KDIM * 2); u.B = B + (size_t)u.pn * (BM * KDIM * 2); return true;
    }
    __device__ __forceinline__ const LAS int* idx(int) const { return nullptr; }
};
__device__ __forceinline__ u32x4 pair16(unsigned a0, unsigned a1, unsigned b0, unsigned b1) {
    const auto r0 = __builtin_amdgcn_permlane16_swap(a0, b0, false, false), r1 = __builtin_amdgcn_permlane16_swap(a1, b1, false, false);
    return (u32x4){(unsigned)r0[0], (unsigned)r1[0], (unsigned)r0[1], (unsigned)r1[1]};
}
struct EpiAct {
    unsigned char* ACT; const float* b1; const LAS float* bl; int wt;
    __device__ __forceinline__ const float* bias_src(const UnitD& u, int lane) const { return b1 + (size_t)u.e * 2048 + u.pn * 128 + (lane < 32 ? lane * 4 : 1024 + (lane - 32) * 4); }
    template <bool WT> __device__ __forceinline__ void run(const f32x4 (&acc)[2][2][4][2], const UnitD& u, int wr, int wc, int fr, int fq) const {
        const int col0 = u.pn * 128 + wc * 32 + 8 * fq; const LAS float* bg = bl + (u.ui & 1) * 256 + wc * 32 + 8 * fq;
        f32x4 bgl[2], bln[2];
#pragma unroll
        for (int n = 0; n < 2; ++n) { bgl[n] = *(const LAS f32x4*)(bg + 4 * n); bln[n] = *(const LAS f32x4*)(bg + 128 + 4 * n) + 1.0f; }
#pragma unroll
        for (int ai = 0; ai < 2; ++ai) { unsigned wq[4][2];
#pragma unroll
            for (int m = 0; m < 4; ++m) { const float rs = 1.0f / 64.0f;
                unsigned w[2];
#pragma unroll
                for (int n = 0; n < 2; ++n) { const f32x4 gl = acc[ai][0][m][n] * rs + bgl[n], ln = acc[ai][1][m][n] * rs + bln[n]; float a[4];
#pragma unroll
                    for (int e = 0; e < 4; e += 2) {
                        const f32x2 gg = (f32x2){fminf(gl[e], 7.0f), fminf(gl[e + 1], 7.0f)}, ll = (f32x2){__builtin_amdgcn_fmed3f(ln[e], -6.0f, 8.0f), __builtin_amdgcn_fmed3f(ln[e + 1], -6.0f, 8.0f)};
                        const f32x2 t = gg * (-1.702f * LOG2E); f32x2 den = (f32x2){__builtin_amdgcn_exp2f(t[0]), __builtin_amdgcn_exp2f(t[1])} + 1.0f;
                        const f32x2 rr = (f32x2){__builtin_amdgcn_rcpf(den[0]), __builtin_amdgcn_rcpf(den[1])}; const f32x2 av = (gg * ll) * rr; a[e] = av[0]; a[e + 1] = av[1]; }
                    int p = 0; p = __builtin_amdgcn_cvt_pk_fp8_f32(a[0], a[1], p, false); p = __builtin_amdgcn_cvt_pk_fp8_f32(a[2], a[3], p, true); w[n] = (unsigned)p; }
                wq[m][0] = w[0]; wq[m][1] = w[1]; }
#pragma unroll
            for (int m = 0; m < 4; m += 2) { const u32x4 v = pair16(wq[m][0], wq[m][1], wq[m + 1][0], wq[m + 1][1]); const int od = fq & 1;
                u32x4* dst = (u32x4*)(ACT + (size_t)(u.pm * BM + ai * HALF + wr * 64 + (m + od) * 16 + fr) * DFF + col0 - 8 * od);
                if constexpr (WT) asm volatile("global_store_dwordx4 %0, %1, off sc1\n\ts_nop 2" :: "v"(dst), "v"(v) : "memory"); else *dst = v; } }
    }
};
struct EpiY {
    unsigned char* Y; const float* b2; const LAS float* bl;
    __device__ __forceinline__ const float* bias_src(const UnitD& u, int lane) const { return b2 + (size_t)u.e * DM + u.pn * BM + lane * 4; }
    __device__ __forceinline__ void operator()(const f32x4 (&acc)[2][2][4][2], const UnitD& u, int wr, int wc, int fr, int fq) const {
        const int col0 = u.pn * BM + wc * 32 + 8 * fq; const LAS float* bb = bl + (u.ui & 1) * 256 + wc * 32 + 8 * fq;
        f32x4 bv[2][2];
#pragma unroll
        for (int bj = 0; bj < 2; ++bj)
#pragma unroll
            for (int n = 0; n < 2; ++n) bv[bj][n] = *(const LAS f32x4*)(bb + bj * HALF + 4 * n);
#pragma unroll
        for (int ai = 0; ai < 2; ++ai)
#pragma unroll
            for (int m = 0; m < 4; m += 2)
#pragma unroll
                for (int bj = 0; bj < 2; ++bj) { unsigned pq[2][2];
#pragma unroll
                    for (int mm = 0; mm < 2; ++mm) { const f32x4 v0 = acc[ai][bj][m + mm][0] * (1.0f / 64.0f) + bv[bj][0], v1 = acc[ai][bj][m + mm][1] * (1.0f / 64.0f) + bv[bj][1];
                        int p0 = 0, p1 = 0; p0 = __builtin_amdgcn_cvt_pk_fp8_f32(v0[0], v0[1], p0, false); p0 = __builtin_amdgcn_cvt_pk_fp8_f32(v0[2], v0[3], p0, true);
                        p1 = __builtin_amdgcn_cvt_pk_fp8_f32(v1[0], v1[1], p1, false); p1 = __builtin_amdgcn_cvt_pk_fp8_f32(v1[2], v1[3], p1, true);
                        pq[mm][0] = (unsigned)p0; pq[mm][1] = (unsigned)p1; }
                    const u32x4 v = pair16(pq[0][0], pq[0][1], pq[1][0], pq[1][1]); const int od = fq & 1;
                    *(u32x4*)(Y + (size_t)(u.pm * BM + ai * HALF + wr * 64 + (m + od) * 16 + fr) * DM + col0 - 8 * od + bj * HALF) = v; }
    }
};
struct EpiMoe {
    EpiAct a; EpiY y; unsigned* cnt;
    __device__ __forceinline__ void bias_prefetch(const UnitD& u, int lane) const { glds16p(u.kind ? y.bias_src(u, lane) : a.bias_src(u, lane), (unsigned)(size_t)a.bl + (unsigned)(u.ui & 1) * 1024u); }
    __device__ __forceinline__ void operator()(const f32x4 (&acc)[2][2][4][2], const UnitD& u, int wr, int wc, int fr, int fq) const {
        if (u.kind == 0) { if (u.pm == a.wt) a.template run<true>(acc, u, wr, wc, fr, fq); else a.template run<false>(acc, u, wr, wc, fr, fq); asm volatile("s_waitcnt vmcnt(0)" ::: "memory"); }
        else y(acc, u, wr, wc, fr, fq);
    }
};
}

namespace att {
typedef LAS const char* lds_cptr;
typedef short v4i16_t __attribute__((ext_vector_type(4)));
__device__ __forceinline__ int crow(int r, int hi) { return (r & 3) + 8 * (r >> 2) + 4 * hi; }
__device__ __forceinline__ void glds16(const void* gsrc, unsigned lds_dst) { unsigned keep;
    asm volatile("s_mov_b32 %0, m0\n\ts_mov_b32 m0, %2\n\ts_nop 0\n\tglobal_load_lds_dwordx4 %1, off\n\ts_mov_b32 m0, %0" : "=&s"(keep) : "v"(gsrc), "s"(lds_dst) : "memory"); }
__device__ __forceinline__ s16x4 vtr(lds_cptr p) { return __builtin_bit_cast(s16x4, __builtin_amdgcn_ds_read_tr16_b64_v4i16((LAS v4i16_t*)p)); }

struct WU {
    const bf16_t* P;
    int seq0;
    int dil, L, hw;
    int J0u, NTU;
    int U0, toff;
    int qcol, kcol, vcol;
    float slope2, negc, sinkp;
    bf16_t* O; int opitch, ocol;
    float* lout; int lstride, lcol;
    const bf16_t* M0; const bf16_t* M1; const float* ML0; const float* ML1;
};

__device__ __forceinline__ void issue_tile(const WU& w, char* base, int t, int lane) {
    const unsigned lds0 = (unsigned)(uintptr_t)base;
    const unsigned kd = (unsigned)__builtin_amdgcn_readfirstlane(lds0 + t * 8192);
#pragma unroll
    for (int i = 0; i < 4; ++i) { const int kl = 8 * i + (lane >> 3); int jk = w.J0u + 32 * t + kl; jk = jk < 0 ? 0 : (jk > w.L - 1 ? w.L - 1 : jk);
        glds16(w.P + (size_t)(w.seq0 + jk * w.dil) * NPROJ + w.kcol + (((lane & 7) ^ ((kl >> 1) & 7)) << 3), kd + i * 1024); }
#pragma unroll
    for (int i = 0; i < 4; ++i) { const int kl = 8 * i + (lane >> 3); int jv = w.J0u + 32 * t + kl; jv = jv < 0 ? 0 : (jv > w.L - 1 ? w.L - 1 : jv);
        glds16(w.P + (size_t)(w.seq0 + jv * w.dil) * NPROJ + w.vcol + (((lane & 7) ^ (((kl >> 1) & 1) << 2)) << 3), kd + 4096 + i * 1024); }
}
__device__ __forceinline__ void load_unit(const WU& w, char* base, int wave, int lane) {
    for (int t = wave; t < w.NTU; t += 8) { const int jf = w.J0u + 32 * t; if (jf + 31 < 0 || jf >= w.L) continue; issue_tile(w, base, t, lane); }
}
__device__ __forceinline__ void load_q(const WU& w, int lane, bf16x8 (&qr)[4]) {
    const int qtok = w.seq0 + (w.U0 + (lane & 31)) * w.dil;
#pragma unroll
    for (int c = 0; c < 4; ++c) qr[c] = *(const bf16x8*)(w.P + (size_t)qtok * NPROJ + w.qcol + c * 16 + (lane >> 5) * 8);
}
__device__ __forceinline__ void compute_unit(const WU& w, char* base, const bf16x8 (&qr)[4], f32x16 (&o)[2], float& lsum_out) {
    const int lane = threadIdx.x & 63, r32 = lane & 31, hi = lane >> 5;
    const lds_cptr b3 = (lds_cptr)base;
    const int HW = w.hw, NT = (32 + 2 * HW) / 32;
    const int J0 = w.U0 - HW;
    const int klo = (-J0 / 32) > 0 ? (-J0 / 32) : 0;
    const int khi = ((w.L - J0) / 32 - 1) < (NT - 1) ? ((w.L - J0) / 32 - 1) : (NT - 1);
    const bool edge = (J0 < 0) || (w.U0 + 32 + HW > w.L);
    f32x16 negcv;
#pragma unroll
    for (int r = 0; r < 16; ++r) negcv[r] = w.negc;
    o[0] = f32x16{}; o[1] = f32x16{};
    float lsum = 0.f;
    const float lof = fmaxf((float)-HW, (float)-(w.U0 + r32)), hif = fminf((float)HW, (float)(w.L - 1 - w.U0 - r32));
    for (int k = klo; k <= khi; ++k) {
        const int sl = w.toff + k;
        const lds_cptr kp = b3 + sl * 8192 + r32 * 128;
        bf16x8 kf[4];
#pragma unroll
        for (int c = 0; c < 4; ++c) kf[c] = *(const LAS bf16x8*)(kp + (((2 * c + hi) ^ ((r32 >> 1) & 7)) << 4));
        bf16x8 vf[2][2];
        { const int vq = (lane & 15) >> 2, vg = (lane >> 4) & 1, vpp = lane & 3, vqb = (vq >> 1) & 1;
          const lds_cptr vbase = b3 + sl * 8192 + 4096 + (4 * hi + vq) * 128 + (2 * vg + (vpp >> 1)) * 16 + (vpp & 1) * 8;
#pragma unroll
          for (int d0 = 0; d0 < 2; ++d0) { const lds_cptr vp = vbase + ((d0 ^ vqb) << 6);
              const s16x4 l0 = vtr(vp), h0 = vtr(vp + 1024), l1 = vtr(vp + 2048), h1 = vtr(vp + 3072);
              vf[d0][0] = (bf16x8){l0[0], l0[1], l0[2], l0[3], h0[0], h0[1], h0[2], h0[3]}; vf[d0][1] = (bf16x8){l1[0], l1[1], l1[2], l1[3], h1[0], h1[1], h1[2], h1[3]}; } }
        __builtin_amdgcn_sched_barrier(0);
        f32x16 s = __builtin_amdgcn_mfma_f32_32x32x16_bf16(kf[0], qr[0], negcv, 0, 0, 0);
        s = __builtin_amdgcn_mfma_f32_32x32x16_bf16(kf[1], qr[1], s, 0, 0, 0);
        s = __builtin_amdgcn_mfma_f32_32x32x16_bf16(kf[2], qr[2], s, 0, 0, 0);
        s = __builtin_amdgcn_mfma_f32_32x32x16_bf16(kf[3], qr[3], s, 0, 0, 0);
        const float cf = (float)(32 * k - HW + 4 * hi - r32);
        const bool masked = edge || (k == 0) || (k == NT - 1);
        const int R0 = 32 * k - HW;
        if (masked) {
#pragma unroll
            for (int r = 0; r < 16; ++r) { const float rel = cf + (float)((r & 3) + 8 * (r >> 2)); const float x = __builtin_fmaf(-w.slope2, __builtin_fabsf(rel), s[r]);
                const float p = __builtin_amdgcn_exp2f(x); s[r] = (rel >= lof && rel <= hif) ? p : 0.f; }
        } else if (R0 != 0) {
            const float sg = R0 < 0 ? w.slope2 : -w.slope2; const f32x2 cf2 = (f32x2){cf, cf}, sg2 = (f32x2){sg, sg};
#pragma unroll
            for (int r = 0; r < 16; r += 2) { const f32x2 c2 = (f32x2){(float)((r & 3) + 8 * (r >> 2)), (float)(((r + 1) & 3) + 8 * ((r + 1) >> 2))};
                const f32x2 x2 = __builtin_elementwise_fma(sg2, cf2 + c2, (f32x2){s[r], s[r + 1]});
                s[r] = __builtin_amdgcn_exp2f(x2[0]); s[r + 1] = __builtin_amdgcn_exp2f(x2[1]); }
        } else {
#pragma unroll
            for (int r = 0; r < 16; ++r) { const float rel = cf + (float)((r & 3) + 8 * (r >> 2)); const float x = __builtin_fmaf(-w.slope2, __builtin_fabsf(rel), s[r]);
                s[r] = __builtin_amdgcn_exp2f(x); }
        }
        { f32x2 a2 = (f32x2){s[0], s[1]} + (f32x2){s[2], s[3]}, b2 = (f32x2){s[4], s[5]} + (f32x2){s[6], s[7]}, c2 = (f32x2){s[8], s[9]} + (f32x2){s[10], s[11]}, d2 = (f32x2){s[12], s[13]} + (f32x2){s[14], s[15]};
          a2 = (a2 + b2) + (c2 + d2); lsum += a2[0] + a2[1]; }
        u32x4 pw0, pw1;
        pw0.x = cvt_pk_bf16(s[0], s[1]); pw0.y = cvt_pk_bf16(s[2], s[3]); pw0.z = cvt_pk_bf16(s[4], s[5]); pw0.w = cvt_pk_bf16(s[6], s[7]);
        pw1.x = cvt_pk_bf16(s[8], s[9]); pw1.y = cvt_pk_bf16(s[10], s[11]); pw1.z = cvt_pk_bf16(s[12], s[13]); pw1.w = cvt_pk_bf16(s[14], s[15]);
#pragma unroll
        for (int d0 = 0; d0 < 2; ++d0) {
            o[d0] = __builtin_amdgcn_mfma_f32_32x32x16_bf16(__builtin_bit_cast(bf16x8, pw0), vf[d0][0], o[d0], 0, 0, 0);
            o[d0] = __builtin_amdgcn_mfma_f32_32x32x16_bf16(__builtin_bit_cast(bf16x8, pw1), vf[d0][1], o[d0], 0, 0, 0);
        }
    }
    lsum += __shfl_xor(lsum, 32);
    lsum += w.sinkp;
    lsum_out = lsum;
}
__device__ __forceinline__ void store_unit(const WU& w, const f32x16 (&o)[2], float lsum, LAS bf16_t* stg, LAS float* wsf) {
    const int lane = threadIdx.x & 63, r32 = lane & 31, hi = lane >> 5;
    if (hi == 0) wsf[r32] = lsum;
    LDS_WAIT();
    float rli[16];
#pragma unroll
    for (int r = 0; r < 16; ++r) rli[r] = __builtin_amdgcn_rcpf(wsf[crow(r, hi)]);
#pragma unroll
    for (int r = 0; r < 16; ++r) { const int orow = crow(r, hi); const unsigned pk = cvt_pk_bf16(o[0][r] * rli[r], o[1][r] * rli[r]);
        stg[orow * 64 + r32] = (bf16_t)(pk & 0xffffu); stg[orow * 64 + 32 + r32] = (bf16_t)(pk >> 16); }
    LDS_WAIT();
#pragma unroll
    for (int i = 0; i < 4; ++i) { const int row = i * 8 + (lane >> 3), ch = lane & 7; u32x4 v = *(const LAS u32x4*)(stg + row * 64 + ch * 8);
        const int tok = w.seq0 + (w.U0 + row) * w.dil;
        if (w.M0) {
            const u32x4 v0 = __builtin_nontemporal_load((const u32x4*)(w.M0 + (size_t)tok * 512 + w.lcol * 64 + ch * 8)), v1 = __builtin_nontemporal_load((const u32x4*)(w.M1 + (size_t)tok * 512 + w.lcol * 64 + ch * 8));
            const float l0 = w.ML0[(size_t)tok * 8 + w.lcol], l1 = w.ML1[(size_t)tok * 8 + w.lcol], l2 = wsf[row];
            const float inv = 1.0f / (l0 + l1 + l2); const float w0 = l0 * inv, w1_ = l1 * inv, w2_ = l2 * inv;
#pragma unroll
            for (int q = 0; q < 4; ++q) { const unsigned a = v0[q], bq = v1[q], c = v[q];
                const float lo = w0 * bf2f(a & 0xffffu) + w1_ * bf2f(bq & 0xffffu) + w2_ * bf2f(c & 0xffffu);
                const float hi2 = w0 * bf2f(a >> 16) + w1_ * bf2f(bq >> 16) + w2_ * bf2f(c >> 16); v[q] = pk2(lo, hi2); }
        }
        *(u32x4*)(w.O + (size_t)tok * w.opitch + w.ocol + ch * 8) = v; }
    if (w.lout && hi == 0) { const int qtok = w.seq0 + (w.U0 + r32) * w.dil; w.lout[(size_t)qtok * w.lstride + w.lcol] = lsum; }
    LDS_WAIT();
}
}

#define XB_TMO      128
#define XB_XCNT(j)  (256  + 64 * (j))
#define XB_XSUB(j)  (1280 + 64 * (j))
#define XB_XGEN(j)  (2304 + 64 * (j))
#define XB_TOP      3328
#define XB_TOPGEN   3392
#define XB_SPIN_CAP (1u << 20)
__device__ __forceinline__ unsigned xb_ld(unsigned* p)              { return __hip_atomic_load(p, __ATOMIC_RELAXED, __HIP_MEMORY_SCOPE_AGENT); }
__device__ __forceinline__ unsigned xb_add(unsigned* p, unsigned v) { return __hip_atomic_fetch_add(p, v, __ATOMIC_RELAXED, __HIP_MEMORY_SCOPE_AGENT); }
__device__ __forceinline__ unsigned xb_xcc_id() { return (unsigned)__builtin_amdgcn_s_getreg((3 << 11) | 20) & 0xFu; }
#define XB_SPIN(cond, bar) do { unsigned _sp = 0; while (cond) { __builtin_amdgcn_s_sleep(1); \
    if ((++_sp & 255u) == 0u) { if (xb_ld(&(bar)[XB_TMO])) break; if (_sp > XB_SPIN_CAP) { atomicAdd(&(bar)[XB_TMO], 1u); break; } } } } while (0)
struct XcdBarrier { unsigned* bar; unsigned x; volatile LAS unsigned* st; };
__device__ __forceinline__ XcdBarrier xcd_barrier_post(unsigned* bar, volatile LAS unsigned* st) {
    XcdBarrier b; b.bar = bar; b.x = xb_xcc_id(); b.st = st;
    if (threadIdx.x == 0) { st[2] = xb_add(&bar[XB_XCNT(b.x)], 1u); st[3] = b.x; }
    return b;
}
__device__ __forceinline__ void xcd_barrier_complete(unsigned* bar, unsigned x, unsigned& nloc, unsigned& nx) {
    const unsigned G = gridDim.x * gridDim.y * gridDim.z;
    unsigned sum, cnt, mine, sp = 0u;
    for (;;) {
        sum = 0u; cnt = 0u; mine = 0u;
#pragma unroll
        for (unsigned j = 0; j < 16; ++j) { const unsigned c = xb_ld(&bar[XB_XCNT(j)]); sum += c; cnt += (c > 0u) ? 1u : 0u; mine = (j == x) ? c : mine; }
        if (sum == G) break;
        __builtin_amdgcn_s_sleep(1);
        if ((++sp & 255u) == 0u) { if (xb_ld(&bar[XB_TMO])) break; if (sp > XB_SPIN_CAP) { atomicAdd(&bar[XB_TMO], 1u); break; } }
    }
    nloc = mine > 0u ? mine : 1u; nx = cnt > 0u ? cnt : 1u;
}
__device__ __forceinline__ void xcd_barrier(const XcdBarrier& b) {
    asm volatile("s_waitcnt vmcnt(0)" ::: "memory");
    __syncthreads();
    if (b.st[0] == 0u) {
        if (threadIdx.x < 64) {
            const unsigned Gn = gridDim.x * gridDim.y * gridDim.z, ln = threadIdx.x; unsigned c = 0u, sp = 0u;
            for (;;) {
                c = ln < 16u ? xb_ld(&b.bar[XB_XCNT(ln)]) : 0u;
                unsigned sum = c;
#pragma unroll
                for (int o = 32; o > 0; o >>= 1) sum += (unsigned)__shfl_xor((int)sum, o);
                if (sum == Gn || ++sp > XB_SPIN_CAP) break;
                __builtin_amdgcn_s_sleep(1);
            }
            const unsigned cnt = (unsigned)__builtin_popcountll(__builtin_amdgcn_ballot_w64(c > 0u));
            const unsigned mine = (unsigned)__builtin_amdgcn_readlane((int)c, (int)__builtin_amdgcn_readfirstlane((int)b.x));
            if (ln == 0u) { b.st[0] = mine > 0u ? mine : 1u; b.st[1] = cnt > 0u ? cnt : 1u; }
        }
        __syncthreads();
    }
    if (threadIdx.x == 0) {
        unsigned* bar = b.bar;
        __builtin_amdgcn_s_waitcnt(0);
        unsigned nloc = b.st[0], nx = b.st[1];
        if (nloc == 0u) { xcd_barrier_complete(bar, b.x, nloc, nx); b.st[0] = nloc; b.st[1] = nx; }
        const unsigned old = xb_add(&bar[XB_XSUB(b.x)], 1u);
        const unsigned gen = old / nloc;
        if (old + 1u == (gen + 1u) * nloc) {
            __builtin_amdgcn_fence(__ATOMIC_RELEASE, "agent");
            asm volatile("s_waitcnt vmcnt(0)" ::: "memory");
            const unsigned og = xb_add(&bar[XB_TOP], 1u);
            const unsigned tgt = (og / nx + 1u) * nx;
            if (og + 1u != tgt) XB_SPIN(xb_ld(&bar[XB_TOP]) < tgt, bar);
            xb_add(&bar[XB_XGEN(b.x)], 1u);
        } else {
            XB_SPIN(xb_ld(&bar[XB_XGEN(b.x)]) == gen, bar);
        }
    }
    __syncthreads();
}

__device__ __forceinline__ void p0_transpose_item(const float* W, int K, int N, bf16_t* WT, LAS unsigned* scr, int kb, int nb, int lane) {
    const int k0 = 64 * kb, n0 = 64 * nb; const float* src = W + (size_t)k0 * N + n0; const int kp = lane >> 4, nc = (lane & 15) * 4;
    f32x4 a[8], b[8];
#pragma unroll
    for (int j = 0; j < 8; ++j) { const int kk = 8 * j + 2 * kp;
        a[j] = __builtin_nontemporal_load((const GAS f32x4*)(src + (size_t)kk * N + nc)); b[j] = __builtin_nontemporal_load((const GAS f32x4*)(src + (size_t)(kk + 1) * N + nc)); }
#pragma unroll
    for (int j = 0; j < 8; ++j) { const int kk = 8 * j + 2 * kp;
        scr[(nc + 0) * 33 + (kk >> 1)] = pk2(a[j][0], b[j][0]); scr[(nc + 1) * 33 + (kk >> 1)] = pk2(a[j][1], b[j][1]);
        scr[(nc + 2) * 33 + (kk >> 1)] = pk2(a[j][2], b[j][2]); scr[(nc + 3) * 33 + (kk >> 1)] = pk2(a[j][3], b[j][3]); }
    LDS_WAIT(); asm volatile("" ::: "memory");
    const int c8 = lane & 7;
#pragma unroll
    for (int i = 0; i < 8; ++i) { const int n = (lane >> 3) + 8 * i; const LAS unsigned* s = scr + n * 33 + 4 * c8;
        u32x4 o; o.x = s[0]; o.y = s[1]; o.z = s[2]; o.w = s[3];
        *(GAS u32x4*)(WT + (size_t)(n0 + n) * K + k0 + 8 * c8) = o; }
    LDS_WAIT(); asm volatile("" ::: "memory");
}

__device__ __forceinline__ void p0_transpose_item_fp8(const float* W, int K, int N, unsigned char* WT, LAS unsigned* scr, int kb, int nb, int lane) {
    const int k0 = 128 * kb, n0 = 64 * nb; const float* src = W + (size_t)k0 * N + n0; const int nc = (lane & 15) * 4;
    LAS unsigned char* T = (LAS unsigned char*)scr;
    f32x4 a[2][16];
#pragma unroll
    for (int j = 0; j < 2; ++j)
#pragma unroll
        for (int q = 0; q < 16; ++q) a[j][q] = __builtin_nontemporal_load((const GAS f32x4*)(src + (size_t)(16 * (4 * j + (lane >> 4)) + q) * N + nc));
#pragma unroll
    for (int j = 0; j < 2; ++j) {
        const int k16 = 4 * j + (lane >> 4);
#pragma unroll
        for (int c = 0; c < 4; ++c) { unsigned w[4];
#pragma unroll
            for (int d = 0; d < 4; ++d) { int p = 0; p = __builtin_amdgcn_cvt_pk_fp8_f32(a[j][4 * d][c] * 64.f, a[j][4 * d + 1][c] * 64.f, p, false); p = __builtin_amdgcn_cvt_pk_fp8_f32(a[j][4 * d + 2][c] * 64.f, a[j][4 * d + 3][c] * 64.f, p, true); w[d] = (unsigned)p; }
            const int n = nc + c; *(LAS u32x4*)(T + n * 128 + ((k16 ^ ((n >> 2) & 7)) << 4)) = (u32x4){w[0], w[1], w[2], w[3]}; }
    }
    LDS_WAIT(); asm volatile("" ::: "memory");
    const int c8 = lane & 7;
#pragma unroll
    for (int i = 0; i < 8; ++i) { const int n = (lane >> 3) + 8 * i; const u32x4 o = *(const LAS u32x4*)(T + n * 128 + ((c8 ^ ((n >> 2) & 7)) << 4));
        __builtin_nontemporal_store(o, (GAS u32x4*)(WT + (size_t)(n0 + n) * K + k0 + 16 * c8)); }
    LDS_WAIT(); asm volatile("" ::: "memory");
}

constexpr int W_ITEMS = 8192 + 4096;
constexpr int P1_ITEMS = 11648;
__device__ __forceinline__ void conv_w_item(int t, const float* w1, const float* w2, unsigned char* W1T, unsigned char* W2T, LAS unsigned* scr, int lane) {
    if (t < 8192) { const int e = t >> 8, q = t & 255; p0_transpose_item_fp8(w1 + (size_t)e * 1024 * 2048, 1024, 2048, W1T + (size_t)e * 2048 * 1024, scr, q >> 5, q & 31, lane); }
    else { const int r = t - 8192, e = r >> 7, q = r & 127; p0_transpose_item_fp8(w2 + (size_t)e * 1024 * 1024, 1024, 1024, W2T + (size_t)e * 1024 * 1024, scr, q >> 4, q & 15, lane); }
}

struct Args { const float* in[16]; float* out; unsigned char* ws; };

__global__ void __launch_bounds__(512, 2) hymba_fwd(Args args) {
    extern __shared__ __attribute__((aligned(16))) unsigned char lds[];
    LAS unsigned char* L3 = (LAS unsigned char*)lds;
    const int tid = threadIdx.x, lane = tid & 63, wave = __builtin_amdgcn_readfirstlane(tid >> 6);
    const int G = gridDim.x; const int bx = blockIdx.x; const int vcu = (G % 8 == 0) ? (bx % 8) * (G / 8) + bx / 8 : bx;
    unsigned* ctl = (unsigned*)(args.ws + WS_CTL);
#define WSP(T, off) ((T*)(args.ws + (off)))
    for (int u = tid; u < (LDS_BYTES - RING_BYTES) / 4; u += 512) ((LAS unsigned*)(L3 + RING_BYTES))[u] = 0u;
    __syncthreads();
    XcdBarrier bar = xcd_barrier_post(ctl + CW_BAR, (volatile LAS unsigned*)(L3 + XT_MISC));
#define GRID_BAR() xcd_barrier(bar)
    const int gw = vcu * 8 + wave, NGW = G * 8;

    {
        LAS unsigned* scr = (LAS unsigned*)(L3 + wave * 16384);
        const float* x = args.in[0]; const float* attn_g = args.in[1]; const float* w_in = args.in[2]; const float* w_out = args.in[8]; const float* w_router = args.in[10]; const float* w1 = args.in[12]; const float* w2 = args.in[14];
        bf16_t* WIN = WSP(bf16_t, WS_WIN); bf16_t* WOUT = WSP(bf16_t, WS_WOUT); bf16_t* WRH = WSP(bf16_t, WS_WRH); bf16_t* WRL = WSP(bf16_t, WS_WRL); unsigned char* W1T = WSP(unsigned char, WS_W1); unsigned char* W2T = WSP(unsigned char, WS_W2); bf16_t* XN = WSP(bf16_t, WS_XN);
        constexpr int I_IN = 16 * 36, I_OUT = 16 * 16, NITEMS = I_IN + I_OUT + (W_ITEMS - P1_ITEMS);
        for (int it = gw; it < NITEMS; it += NGW) {
            int r = it;
            if (r < I_IN) { p0_transpose_item(w_in, 1024, NPROJ, WIN, scr, r / 36, r % 36, lane); continue; } r -= I_IN;
            if (r < I_OUT) { p0_transpose_item(w_out, 1024, 1024, WOUT, scr, r / 16, r % 16, lane); continue; } r -= I_OUT;
            conv_w_item(P1_ITEMS + r, w1, w2, W1T, W2T, scr, lane);
        }
        for (int m = gw; m < MTOK; m += 2 * NGW) {
            const int m2 = m + NGW;
            const GAS f32x4* xr = (const GAS f32x4*)(x + (size_t)m * DM) + lane; const GAS f32x4* xr2 = (const GAS f32x4*)(x + (size_t)m2 * DM) + lane; const GAS f32x4* gr = (const GAS f32x4*)attn_g + lane;
            f32x4 v[4], v2[4]; float s = 0.f, s2 = 0.f;
#pragma unroll
            for (int j = 0; j < 4; ++j) { v[j] = __builtin_nontemporal_load(xr + 64 * j); v2[j] = __builtin_nontemporal_load(xr2 + 64 * j); }
#pragma unroll
            for (int j = 0; j < 4; ++j) { s += (v[j][0] * v[j][0] + v[j][1] * v[j][1]) + (v[j][2] * v[j][2] + v[j][3] * v[j][3]); s2 += (v2[j][0] * v2[j][0] + v2[j][1] * v2[j][1]) + (v2[j][2] * v2[j][2] + v2[j][3] * v2[j][3]); }
            const float rstd = __builtin_amdgcn_rsqf(wave_sum(s) * (1.f / DM) + NORM_EPS), rstd2 = __builtin_amdgcn_rsqf(wave_sum(s2) * (1.f / DM) + NORM_EPS);
            GAS u32x2* o8 = (GAS u32x2*)(XN + (size_t)m * DM) + lane; GAS u32x2* o82 = (GAS u32x2*)(XN + (size_t)m2 * DM) + lane;
#pragma unroll
            for (int j = 0; j < 4; ++j) { const f32x4 g = gr[64 * j]; u32x2 o; o.x = pk2(v[j][0] * rstd * g[0], v[j][1] * rstd * g[1]); o.y = pk2(v[j][2] * rstd * g[2], v[j][3] * rstd * g[3]); o8[64 * j] = o;
                u32x2 o2; o2.x = pk2(v2[j][0] * rstd2 * g[0], v2[j][1] * rstd2 * g[1]); o2.y = pk2(v2[j][2] * rstd2 * g[2], v2[j][3] * rstd2 * g[3]); o82[64 * j] = o2; }
        }
        for (int i = vcu * 512 + tid; i < NE * 1024; i += G * 512) { const int e = i >> 10, k = i & 1023; const float wv = w_router[(size_t)k * NE + e]; const unsigned h = f2bf(wv);
            WRH[i] = (bf16_t)h; WRL[i] = (bf16_t)f2bf(wv - bf2f(h)); }
    }
    GRID_BAR();


    {
        const int q8 = bx >> 3, q16 = q8 & 15;
        if (q16 >= 9) {
            LAS unsigned* scr = (LAS unsigned*)(L3 + wave * 16384);
            const int cw = ((((q8 >> 4) * 7 + (q16 - 9)) * 8 + (bx & 7)) * 8) + wave;
            for (int t = cw; t < P1_ITEMS; t += 896) conv_w_item(t, args.in[12], args.in[14], WSP(unsigned char, WS_W1), WSP(unsigned char, WS_W2), scr, lane);
        } else {
            pg8::StaticOrder S; S.init(MTOK, NPROJ, 144, ((q8 >> 4) * 9 + q16) * 8 + (bx & 7), WSP(bf16_t, WS_XN), WSP(bf16_t, WS_WIN));
            pg8::EpiQKV E{WSP(bf16_t, WS_QKV), args.in[3], args.in[4], args.in[6], args.in[7]};
            pg8::gemm_phase<pg8::EpiQKV, pg8::StaticOrder, 2, false, false>(L3, S, E, 32u * 1024u * 2u);
        }
    }
    GRID_BAR();


    int ru, cP, cN, cmyx; bool flow4 = (G == 256), flow8 = (G == 256), creg8 = (G == 256);
    float ga0 = fabsf(args.in[3][lane]), gb0 = fabsf(args.in[4][lane]), gc0 = fabsf(args.in[6][lane]), gd0 = fabsf(args.in[7][lane]); const float sinkv0 = args.in[5][lane & 7];
    { LAS int* xc0 = (LAS int*)(L3 + XT_MISC + 16);
      if (tid < 16) xc0[tid] = (int)xb_ld(ctl + CW_BAR + XB_XCNT(tid));
      __syncthreads();
      const int myx = ((volatile LAS int*)(L3 + XT_MISC))[3]; int P = 0, n = 1;
      for (int j = 0; j < 16; ++j) { const int c = xc0[j]; P += (j < myx) ? c : 0; n = (j == myx) ? c : n; flow4 = flow4 && ((c & 3) == 0); flow8 = flow8 && ((c & 7) == 0); creg8 = creg8 && (c == (j < 8 ? 32 : 0)); }
      cP = __builtin_amdgcn_readfirstlane(P); cN = __builtin_amdgcn_readfirstlane(n); cmyx = __builtin_amdgcn_readfirstlane(myx);
      ru = __builtin_amdgcn_readfirstlane(flow4 ? P + ((volatile LAS int*)(L3 + XT_MISC))[2] : vcu); }
    {
        const float* a_qg = args.in[3]; const float* a_kg = args.in[4]; const float* a_sinks = args.in[5]; const float* b_qg = args.in[6]; const float* b_kg = args.in[7];
        bf16_t* QKV = WSP(bf16_t, WS_QKV); bf16_t* OB = WSP(bf16_t, WS_OB); bf16_t* ATT = WSP(bf16_t, WS_ATT); float* LB = WSP(float, WS_LB);
        float ga = ga0, gb = gb0, gc = gc0, gd = gd0;
        ga = wave_max(ga); gb = wave_max(gb); gc = wave_max(gc); gd = wave_max(gd);
        const float boundA = 8.0f * LOG2E * ga * gb + 0.25f, boundB = 8.0f * LOG2E * gc * gd + 0.25f;
        LAS bf16_t* stg = (LAS bf16_t*)(L3 + 98304 + wave * 4096);
        LAS float* wsf = (LAS float*)(L3 + XT_IDX + wave * 128);
#define ATT_RUN_UNIT(w) do { att::load_unit(w, (char*)lds, wave, lane); bf16x8 qr[4]; att::load_q(w, lane, qr); asm volatile("s_waitcnt vmcnt(0)" ::: "memory"); __syncthreads(); \
            f32x16 o[2]; float lsum; att::compute_unit(w, (char*)lds, qr, o, lsum); att::store_unit(w, o, lsum, stg, wsf); \
            LDS_WAIT(); __builtin_amdgcn_s_barrier(); } while (0)
        auto mk_b = [&](att::WU& w, int b, int hb, int br, int sub) __attribute__((always_inline)) {
            int rho, qb;
            if (br == 0) { w.dil = 1; rho = 0; qb = sub; } else if (br == 1) { w.dil = 4; rho = sub >> 2; qb = sub & 3; } else { w.dil = 16; rho = sub; qb = 0; }
            w.seq0 = b * SEQ + rho; w.L = SEQ / w.dil; w.hw = 64; w.J0u = qb * 256 - 64; w.NTU = 12; w.U0 = qb * 256 + 32 * wave; w.toff = wave;
            w.qcol = COL_QB + hb * 64; w.kcol = COL_KB + hb * 64; w.vcol = COL_VB + hb * 64;
            w.slope2 = exp2f(-0.5f * (float)(8 + hb + 1)) * (float)w.dil * LOG2E; w.negc = -boundB; w.sinkp = 0.f; w.lcol = hb;
            if (br < 2) { w.O = OB + (size_t)br * MTOK * 512; w.opitch = 512; w.ocol = hb * 64; w.lout = LB + (size_t)br * MTOK * 8; w.lstride = 8; w.M0 = nullptr; w.M1 = nullptr; w.ML0 = nullptr; w.ML1 = nullptr; }
            else { w.O = ATT; w.opitch = DM; w.ocol = 512 + hb * 64; w.lout = nullptr; w.lstride = 0; w.M0 = OB; w.M1 = OB + (size_t)MTOK * 512; w.ML0 = LB; w.ML1 = LB + (size_t)MTOK * 8; }
        };
        const float sinkv = sinkv0;
        const int rb = flow8 ? ru : vcu;
        for (int ui = 0; ui < 8; ++ui) {
            att::WU w; w.P = QKV;
            if (ui == 4) { asm volatile("s_waitcnt vmcnt(0)" ::: "memory"); __builtin_amdgcn_s_barrier();
                if (tid == 0) __hip_atomic_fetch_add(ctl + CW_P2 + (rb >> 3) * 16, 1u, __ATOMIC_RELAXED, __HIP_MEMORY_SCOPE_AGENT); }
            if (ui == 6) {
                if (flow8) { if (tid == 0) { unsigned c = 0, sp = 0; const unsigned* p = ctl + CW_P2 + (rb >> 3) * 16;
                        while (c < 8u && ++sp < (1u << 20)) { c = __hip_atomic_load(p, RLX_AGENT); if (c < 8u) __builtin_amdgcn_s_sleep(1); } }
                    __syncthreads(); }
                else { asm volatile("s_waitcnt vmcnt(0)" ::: "memory"); GRID_BAR(); }
            }
            if (ui == 4 || ui == 5) {
                const int ua = vcu * 2 + (ui - 4), b = ua >> 7, kvh = (ua >> 6) & 1, qb = ua & 63, head = kvh * 4 + (wave >> 1);
                w.seq0 = b * SEQ; w.dil = 1; w.L = SEQ; w.hw = 128; w.J0u = qb * 64 - 128; w.NTU = 10; w.U0 = qb * 64 + 32 * (wave & 1); w.toff = wave & 1;
                w.qcol = COL_QA + head * 64; w.kcol = COL_KA + kvh * 64; w.vcol = COL_VA + kvh * 64;
                w.slope2 = exp2f(-0.5f * (float)(head + 1)) * LOG2E; w.negc = -boundA; w.sinkp = exp2f(__builtin_bit_cast(float, __builtin_amdgcn_readlane(__builtin_bit_cast(int, sinkv), head)) * LOG2E - boundA);
                w.O = ATT; w.opitch = DM; w.ocol = head * 64; w.lout = nullptr; w.lstride = 0; w.lcol = 0; w.M0 = nullptr; w.M1 = nullptr; w.ML0 = nullptr; w.ML1 = nullptr;
            } else if (ui < 4) { const int ux = rb * 4 + ui; mk_b(w, ux >> 8, (ux >> 5) & 7, (ux >> 4) & 1, ux & 15); }
            else { const int uy = rb * 2 + (ui - 6); mk_b(w, uy >> 7, (uy >> 4) & 7, 2, uy & 15); }
            ATT_RUN_UNIT(w);
        }
        asm volatile("s_waitcnt vmcnt(0)" ::: "memory");
    }
    GRID_BAR();

    {
        pg8::RowOrder S; S.nwg = (MTOK / 256) * 4; S.G = G; S.c = ru; S.A = (const char*)WSP(bf16_t, WS_ATT); S.B = (const char*)WSP(bf16_t, WS_WOUT);
        pg8::EpiX1F E{pg8::EpiX1{args.in[0], WSP(float, WS_X1)}, ctl + CW_RT3};
        pg8::gemm_phase<pg8::EpiX1F, pg8::RowOrder, 0, false, false>(L3, S, E, 128u * 1024u * 2u);
    }
    if (flow4) {
        if (tid == 0) { unsigned c = 0, sp = 0; const unsigned* p = ctl + CW_RT3 + (ru >> 2) * 16;
            while (c < 32u && ++sp < (1u << 20)) { c = __hip_atomic_load(p, RLX_AGENT); if (c < 32u) __builtin_amdgcn_s_sleep(1); } }
        __syncthreads();
    } else GRID_BAR();


    {
        LAS int* hist = (LAS int*)(L3 + XT_HIST); LAS int* hbase = (LAS int*)(L3 + XT_BASE);
        const float* ffn_g = args.in[9]; const float* b_router = args.in[11]; const float* out = WSP(float, WS_X1);
        bf16_t* WRH = WSP(bf16_t, WS_WRH); bf16_t* WRL = WSP(bf16_t, WS_WRL); unsigned char* HN = WSP(unsigned char, WS_HN);
        float* RT = WSP(float, WS_RT); int* TOPE = WSP(int, WS_TOPE); int* TOPS = WSP(int, WS_TOPS); float* GATE = WSP(float, WS_GATE); int* LIST = WSP(int, WS_LIST);
        if (tid < 32) hist[tid] = 0;
        __syncthreads();
        const int r32 = lane & 31, hi = lane >> 5, grp = wave >> 2, kq = wave & 3;
        int te[4] = {0, 0, 0, 0}, tsl[4] = {0, 0, 0, 0}; float tg[4] = {0.f, 0.f, 0.f, 0.f};
        const int tok = ru * 64 + grp * 32 + r32;
        LAS float* rstd_l = (LAS float*)(L3 + 101376);
        { f32x4 pa[8][4];
#pragma unroll
          for (int rr = 0; rr < 8; ++rr)
#pragma unroll
            for (int j = 0; j < 4; ++j) pa[rr][j] = ((const GAS f32x4*)(out + (size_t)(ru * 64 + wave * 8 + rr) * DM) + lane)[64 * j];
#pragma unroll
          for (int rr = 0; rr < 8; ++rr) { float sq = 0.f;
#pragma unroll
            for (int j = 0; j < 4; ++j) { const f32x4 v = pa[rr][j]; sq += (v[0] * v[0] + v[1] * v[1]) + (v[2] * v[2] + v[3] * v[3]); }
            sq = wave_sum(sq); if (lane == 0) rstd_l[wave * 8 + rr] = __builtin_amdgcn_rsqf(sq * (1.f / DM) + NORM_EPS); } }
        __syncthreads();
        f32x16 acc = f32x16{};
        {
            constexpr int PITCH = 528;
            LAS unsigned char* XH = L3; LAS unsigned char* XL = L3 + 33792; LAS unsigned char* WH = L3 + 67584; LAS unsigned char* WL = L3 + 84480;
            f32x4 g4, xv[8]; u32x4 wv[4];
#define P4_LOAD(c) do { g4 = *(const f32x4*)(ffn_g + 256 * (c) + 4 * lane); \
                _Pragma("unroll") for (int rr = 0; rr < 8; ++rr) xv[rr] = *(const GAS f32x4*)(out + (size_t)(ru * 64 + wave * 8 + rr) * DM + 256 * (c) + 4 * lane); \
                _Pragma("unroll") for (int i = 0; i < 2; ++i) { const int e = 4 * wave + 2 * i + (lane >> 5); wv[i] = *(const GAS u32x4*)(WRH + (size_t)e * 1024 + 256 * (c) + 8 * (lane & 31)); wv[2 + i] = *(const GAS u32x4*)(WRL + (size_t)e * 1024 + 256 * (c) + 8 * (lane & 31)); } } while (0)
            P4_LOAD(0);
            for (int c = 0; c < 4; ++c) {
#pragma unroll
                for (int rr = 0; rr < 8; ++rr) { const int row = wave * 8 + rr; const float rs = rstd_l[row];
                    const float v0 = xv[rr][0] * g4[0] * rs, v1 = xv[rr][1] * g4[1] * rs, v2 = xv[rr][2] * g4[2] * rs, v3 = xv[rr][3] * g4[3] * rs;
                    int p = 0; p = __builtin_amdgcn_cvt_pk_fp8_f32(v0, v1, p, false); p = __builtin_amdgcn_cvt_pk_fp8_f32(v2, v3, p, true);
                    *(GAS unsigned*)(HN + (size_t)(ru * 64 + row) * DM + 256 * c + 4 * lane) = (unsigned)p;
                    const unsigned h01 = pk2(v0, v1), h23 = pk2(v2, v3);
                    *(LAS u32x2*)(XH + row * PITCH + 8 * lane) = (u32x2){h01, h23};
                    *(LAS u32x2*)(XL + row * PITCH + 8 * lane) = (u32x2){pk2(v0 - __builtin_bit_cast(float, h01 << 16), v1 - __builtin_bit_cast(float, h01 & 0xffff0000u)),
                                                                         pk2(v2 - __builtin_bit_cast(float, h23 << 16), v3 - __builtin_bit_cast(float, h23 & 0xffff0000u))}; }
#pragma unroll
                for (int i = 0; i < 2; ++i) { const int e = 4 * wave + 2 * i + (lane >> 5); *(LAS u32x4*)(WH + e * PITCH + 16 * (lane & 31)) = wv[i]; *(LAS u32x4*)(WL + e * PITCH + 16 * (lane & 31)) = wv[2 + i]; }
                __syncthreads();
                if (c < 3) P4_LOAD(c + 1);
#pragma unroll
                for (int ss = 0; ss < 4; ++ss) { const int ko = (16 * (kq * 4 + ss) + 8 * hi) * 2;
                    const bf16x8 xh = *(const LAS bf16x8*)(XH + (grp * 32 + r32) * PITCH + ko), xl = *(const LAS bf16x8*)(XL + (grp * 32 + r32) * PITCH + ko);
                    const bf16x8 wa = *(const LAS bf16x8*)(WH + r32 * PITCH + ko), wb = *(const LAS bf16x8*)(WL + r32 * PITCH + ko);
                    acc = __builtin_amdgcn_mfma_f32_32x32x16_bf16(wa, xh, acc, 0, 0, 0);
                    acc = __builtin_amdgcn_mfma_f32_32x32x16_bf16(wa, xl, acc, 0, 0, 0);
                    acc = __builtin_amdgcn_mfma_f32_32x32x16_bf16(wb, xh, acc, 0, 0, 0); }
                __syncthreads();
            }
#undef P4_LOAD
        }
        LAS float* red = (LAS float*)L3;
#pragma unroll
        for (int r = 0; r < 16; ++r) red[(wave * 17 + r) * 64 + lane] = acc[r];
        __syncthreads();
        if (kq == 0) {
#pragma unroll
            for (int q = 1; q < 4; ++q) {
#pragma unroll
                for (int r = 0; r < 16; ++r) acc[r] += red[((wave + q) * 17 + r) * 64 + lane]; }
            float lg[32];
#pragma unroll
            for (int r = 0; r < 16; ++r) { const float own = acc[r], oth = __shfl_xor(own, 32); const int e0 = (r & 3) + 8 * (r >> 2);
                const float v0 = hi ? oth : own, v1 = hi ? own : oth;
                lg[e0] = v0 + b_router[e0]; lg[e0 + 4] = v1 + b_router[e0 + 4]; }
            float tv[4];
#pragma unroll
            for (int kk = 0; kk < 4; ++kk) { float best = -INFINITY; int bi = 0;
#pragma unroll
                for (int e = 0; e < 32; ++e) { if (lg[e] > best) { best = lg[e]; bi = e; } }
#pragma unroll
                for (int e = 0; e < 32; ++e) { if (e == bi) lg[e] = -INFINITY; }
                tv[kk] = best; te[kk] = bi; }
            float ex[4], sum = 0.f;
#pragma unroll
            for (int kk = 0; kk < 4; ++kk) { ex[kk] = __expf(tv[kk] - tv[0]); sum += ex[kk]; }
#pragma unroll
            for (int kk = 0; kk < 4; ++kk) tg[kk] = ex[kk] / sum;
            if (hi == 0) {
#pragma unroll
                for (int kk = 0; kk < 4; ++kk) tsl[kk] = __hip_atomic_fetch_add(&hist[te[kk]], 1, __ATOMIC_RELAXED, __HIP_MEMORY_SCOPE_WORKGROUP);
            }
        }
        __syncthreads();
        if (tid < 32) hbase[tid] = (int)atomicAdd(ctl + CW_CNT + 64 * tid, (unsigned)hist[tid]);
        __syncthreads();
        if (kq == 0 && hi == 0) {
#pragma unroll
            for (int kk = 0; kk < 4; ++kk) { const int e = te[kk], slot = hbase[e] + tsl[kk]; LIST[(size_t)e * LISTCAP + slot] = tok; TOPE[tok * 4 + kk] = e; TOPS[tok * 4 + kk] = slot; GATE[tok * 4 + kk] = tg[kk]; }
        }
    }
    GRID_BAR();


    LAS int* tp = (LAS int*)(L3 + XT_TP); LAS int* cntl = (LAS int*)(L3 + XT_CNT); LAS int* ixt = (LAS int*)(L3 + XT_IDX);
    if (tid < NE) cntl[tid] = (int)__hip_atomic_load(ctl + CW_CNT + 64 * tid, RLX_AGENT);
    __syncthreads();
    if (tid < 64) {
        const int nt_e = (tid < NE) ? ((cntl[tid & 31] + 255) >> 8) : 0; int inc = nt_e;
#pragma unroll
        for (int o = 1; o < 32; o <<= 1) { const int up = __shfl_up(inc, o); inc += ((tid & 63) >= o) ? up : 0; }
        if (tid < NE) tp[tid] = inc - nt_e; if (tid == NE - 1) tp[NE] = inc; }
    __syncthreads();
    const int NTILES = __builtin_amdgcn_readfirstlane(tp[NE]);
    int fq_, fn_, fr0_, fnr_, fndo_, fnd_, frin_, fwt_;
    { const int myx = cmyx, P = cP;
      fq_ = __builtin_amdgcn_readfirstlane(((volatile LAS int*)(L3 + XT_MISC))[2]); fn_ = cN;
      fr0_ = (NTILES * P) / G; fnr_ = (NTILES * (P + fn_)) / G - fr0_;
      const bool reg8 = creg8;
      const int Rc = (12 * NTILES + G - 1) / G, xp = (myx + 7) & 7;
      const int nr_m = fnr_, nr_n = ((NTILES * (((myx + 1) & 7) + 1)) >> 3) - ((NTILES * ((myx + 1) & 7)) >> 3), r0_p = (NTILES * xp) >> 3, nr_p = ((NTILES * (xp + 1)) >> 3) - r0_p;
      const bool mv_out = reg8 && (12 * nr_m > 32 * Rc) && (12 * nr_m - 4 <= 32 * Rc) && (12 * nr_n + 4 <= 32 * Rc);
      const bool mv_in = reg8 && (12 * nr_p > 32 * Rc) && (12 * nr_p - 4 <= 32 * Rc) && (12 * nr_m + 4 <= 32 * Rc);
      fndo_ = __builtin_amdgcn_readfirstlane((fnr_ - (mv_out ? 1 : 0)) * 4); fnd_ = __builtin_amdgcn_readfirstlane(fndo_ + (mv_in ? 4 : 0)); frin_ = __builtin_amdgcn_readfirstlane(mv_in ? r0_p + nr_p - 1 : 0);
      fwt_ = __builtin_amdgcn_readfirstlane(mv_out ? fr0_ + fnr_ - 1 : -1); }
    {
        int* LISTp = WSP(int, WS_LIST);
        int val[12];
#pragma unroll
        for (int j = 0; j < 12; ++j) { const int idx = tid + 512 * j, i = idx >> 8, r = idx & 255; const int L = i * fn_ + fq_, L2 = L - fnr_ * 8;
            const bool up = L2 < 0; const int rt = up ? fr0_ + (L >> 3) : 0;
            const int e = __builtin_popcountll(__builtin_amdgcn_ballot_w64(lane < NE - 1 && rt >= tp[lane < NE - 1 ? lane + 1 : NE]));
            const int n = cntl[e]; int sl = (rt - tp[e]) * 256 + r; sl = sl < n ? sl : n - 1; sl = sl < 0 ? 0 : sl;
            const int lv = LISTp[(size_t)e * LISTCAP + sl];
            val[j] = up ? lv : (L2 < fndo_ ? fr0_ + (L2 >> 2) : frin_) * 256 + r; }
#pragma unroll
        for (int j = 0; j < 12; ++j) { const int idx = tid + 512 * j, i = idx >> 8; const int L2 = i * fn_ + fq_ - fnr_ * 8; if (L2 < fnd_) ixt[idx] = val[j]; }
    }
    __syncthreads();

    {
        pg8::MoeFlow S; S.q = fq_; S.n = fn_; S.r0 = fr0_; S.nr = fnr_; S.ndo = fndo_; S.nd = fnd_; S.rin = frin_; S.tp = tp; S.ixt = ixt; S.ws = (const char*)args.ws; S.cnt = ctl + CW_RTC;
        pg8::EpiMoe E{pg8::EpiAct{WSP(unsigned char, WS_ACT), args.in[13], (const LAS float*)(L3 + XT_BIAS), fwt_}, pg8::EpiY{WSP(unsigned char, WS_Y), args.in[15], (const LAS float*)(L3 + XT_BIAS)}, ctl + CW_RTC};
        pg8::gemm_phase<pg8::EpiMoe, pg8::MoeFlow, 1, true, true, true>(L3, S, E, 0u);
    }
    GRID_BAR();


    { float* out = args.out; int* TOPE = WSP(int, WS_TOPE); int* TOPS = WSP(int, WS_TOPS); float* GATE = WSP(float, WS_GATE); unsigned char* YB = WSP(unsigned char, WS_Y);
    for (int m0 = gw * 8; m0 < MTOK; m0 += NGW * 8) {
        int rowv = 0; float gatev = 0.f;
        if (lane < 32) { const int e = TOPE[m0 * 4 + lane], slot = TOPS[m0 * 4 + lane]; gatev = GATE[m0 * 4 + lane]; rowv = tp[e] * 256 + slot; }
#pragma unroll 2
        for (int t = 0; t < 8; ++t) {
            GAS f32x4* orow = (GAS f32x4*)(out + (size_t)(m0 + t) * DM) + lane; const GAS f32x4* xrow = (const GAS f32x4*)(WSP(float, WS_X1) + (size_t)(m0 + t) * DM) + lane;
            f32x4 v[4]; unsigned y[4][4]; float gt[4];
#pragma unroll
            for (int kk = 0; kk < 4; ++kk) { const int row = __shfl(rowv, t * 4 + kk); gt[kk] = __shfl(gatev, t * 4 + kk);
                const GAS unsigned* yr = (const GAS unsigned*)(YB + (size_t)row * DM) + lane;
#pragma unroll
                for (int j = 0; j < 4; ++j) y[kk][j] = __builtin_nontemporal_load(yr + 64 * j); }
#pragma unroll
            for (int j = 0; j < 4; ++j) v[j] = __builtin_nontemporal_load(xrow + 64 * j);
#pragma unroll
            for (int kk = 0; kk < 4; ++kk)
#pragma unroll
                for (int j = 0; j < 4; ++j) { const f32x2 lo = __builtin_amdgcn_cvt_pk_f32_fp8((int)y[kk][j], false), hi2 = __builtin_amdgcn_cvt_pk_f32_fp8((int)y[kk][j], true);
                    v[j][0] += gt[kk] * lo[0]; v[j][1] += gt[kk] * lo[1]; v[j][2] += gt[kk] * hi2[0]; v[j][3] += gt[kk] * hi2[1]; }
#pragma unroll
            for (int j = 0; j < 4; ++j) __builtin_nontemporal_store(v[j], orow + 64 * j);
        }
    } }
}

extern "C" void kernel_launch(void* const* d_in, const int* in_sizes, int n_in, void* d_out, int out_size, void* d_ws, size_t ws_size, hipStream_t stream) {
    static int grid = 0;
    if (grid == 0) {
        if (n_in != 16 || out_size != MTOK * DM || ws_size < WS_END) { fprintf(stderr, "kernel_launch: unexpected shapes (n_in %d, out %d, ws %zu)\n", n_in, out_size, ws_size); grid = -1; return; }
        int dev = 0, cus = 0, per_cu = 0;
        if (hipGetDevice(&dev) != hipSuccess || hipDeviceGetAttribute(&cus, hipDeviceAttributeMultiprocessorCount, dev) != hipSuccess) { grid = -1; return; }
        if (hipFuncSetAttribute((const void*)hymba_fwd, hipFuncAttributeMaxDynamicSharedMemorySize, LDS_BYTES) != hipSuccess) { fprintf(stderr, "kernel_launch: hipFuncSetAttribute failed\n"); grid = -1; return; }
        if (hipOccupancyMaxActiveBlocksPerMultiprocessor(&per_cu, (const void*)hymba_fwd, 512, LDS_BYTES) != hipSuccess || per_cu < 1) { fprintf(stderr, "kernel_launch: occupancy query reports %d blocks per CU\n", per_cu); per_cu = 1; }
        (void)hipGetLastError();
        grid = cus;
        if (grid != 256) fprintf(stderr, "kernel_launch: %d CUs; the attention phase assumes 256 workgroups\n", grid);
    }
    if (grid < 0) return;
    (void)hipMemsetAsync((char*)d_ws + WS_CTL, 0, CTL_ZERO_BYTES, stream);
    Args a{};
    for (int i = 0; i < 16; ++i) a.in[i] = (const float*)d_in[i];
    a.out = (float*)d_out; a.ws = (unsigned char*)d_ws;
    void* params[] = {&a};
    hipError_t e = hipLaunchCooperativeKernel((const void*)hymba_fwd, dim3(grid), dim3(512), params, LDS_BYTES, stream);
    if (e != hipSuccess) fprintf(stderr, "kernel_launch: cooperative launch failed: %s (grid %d)\n", hipGetErrorString(e), grid);
}
```
